# Optimizing an MI355X kernel written in HIP

```python
import math
import jax, jax.numpy as jnp
from jax import lax
import numpy as np

D_MODEL = 1024
BATCH = 8
SEQ = 2048
DEPTH = 4

MEM_LEN = 256
N_BRANCH = 4
BRANCH_WIDTH = D_MODEL // 4
RW_HEADS = 4
RW_HEAD_DIM = BRANCH_WIDTH // RW_HEADS
RW_DECAY_RANK = 64
RW_AAA_RANK = 64
RW_GATE_RANK = 160
RW_LN_EPS = 64e-5
RW_SHIFT_COLS = 3 * BRANCH_WIDTH + RW_DECAY_RANK + RW_AAA_RANK + RW_GATE_RANK
CONV_CH = BRANCH_WIDTH
CONV_WIDTH = 31
GLA_HEADS = 4
GLA_DK = BRANCH_WIDTH // 2 // GLA_HEADS
GLA_DV = BRANCH_WIDTH // GLA_HEADS
GLA_GATE_RANK = 16
GLA_TAU = 16.0
GLA_CHUNK = 64
GLA_EPS = 1e-5
FOX_HEADS = 4
FOX_HEAD_DIM = BRANCH_WIDTH // FOX_HEADS
FOX_BLOCK = 128
XA_HEADS = 4
XA_HEAD_DIM = D_MODEL // XA_HEADS
D_FF = ((8 * D_MODEL + 3 * 256 - 1) // (3 * 256)) * 256
ALPHA = (2.0 * DEPTH) ** 0.25
BETA = (8.0 * DEPTH) ** -0.25
LN_EPS = 1e-5

COL_SIZES = (
    RW_SHIFT_COLS,
    2 * CONV_CH,
    GLA_HEADS * GLA_DK,
    GLA_HEADS * GLA_DK,
    GLA_HEADS * GLA_DV,
    GLA_HEADS * GLA_DV,
    GLA_GATE_RANK,
    FOX_HEADS * FOX_HEAD_DIM,
    FOX_HEADS * FOX_HEAD_DIM,
    FOX_HEADS * FOX_HEAD_DIM,
    FOX_HEADS,
    N_BRANCH * D_MODEL,
)
D_IN = sum(COL_SIZES)

kernel_name = "hybrid_rwkv7_conv_gla_fox_deepnorm"


def _split(a, sizes):
    out, start = [], 0
    for s in sizes:
        out.append(a[..., start:start + s])
        start += s
    return out


def _layer_norm(x, g, b, eps=LN_EPS):
    xf = x.astype(jnp.float32)
    mu = jnp.mean(xf, axis=-1, keepdims=True)
    var = jnp.mean(jnp.square(xf - mu), axis=-1, keepdims=True)
    return ((xf - mu) * lax.rsqrt(var + eps)).astype(x.dtype) * g + b


def _token_shift(p, mu):
    prev = jnp.pad(p, ((0, 0), (1, 0), (0, 0)))[:, :-1]
    return p + (prev - p) * mu


def _rwkv7_scan(r, decay, k, v, a, b):
    Bsz, T, H, N = r.shape

    def step(S, inp):
        r_t, w_t, k_t, v_t, a_t, b_t = inp
        sa = jnp.einsum('bhij,bhj->bhi', S, a_t)
        S = (S * w_t[:, :, None, :] + sa[..., None] * b_t[:, :, None, :]
             + v_t[..., None] * k_t[:, :, None, :])
        return S, jnp.einsum('bhij,bhj->bhi', S, r_t)

    xs = tuple(jnp.moveaxis(t, 1, 0) for t in (r, decay, k, v, a, b))
    S0 = jnp.zeros((Bsz, H, N, N), jnp.float32)
    _, y = lax.scan(step, S0, xs)
    return jnp.moveaxis(y, 0, 1)


def _rwkv7_branch(p_rw, mu, w0, w2, a0, a2, g2, k_k, k_a, r_k, ln_g, ln_b):
    Bsz, T, _ = p_rw.shape
    dt = p_rw.dtype
    p = _token_shift(p_rw, mu)
    r, k, v, xw, xa, xg = _split(p, (BRANCH_WIDTH, BRANCH_WIDTH, BRANCH_WIDTH,
                                     RW_DECAY_RANK, RW_AAA_RANK, RW_GATE_RANK))
    w_log = -jax.nn.softplus(-(w0 + jnp.tanh(xw) @ w2).astype(jnp.float32)) - 0.5
    decay = jnp.exp(-jnp.exp(w_log))
    a = jax.nn.sigmoid((a0 + xa @ a2).astype(jnp.float32))
    g = jax.nn.sigmoid(xg) @ g2
    hs = lambda t: t.astype(jnp.float32).reshape(Bsz, T, RW_HEADS, RW_HEAD_DIM)
    kk = hs(k * k_k)
    kk = kk / jnp.maximum(jnp.sqrt(jnp.sum(kk * kk, axis=-1, keepdims=True)), 1e-12)
    k_mod = k.astype(jnp.float32) * (1.0 + (a - 1.0) * k_a.astype(jnp.float32))
    rh, kh, vh, ah, dh = hs(r), hs(k_mod), hs(v), hs(a), hs(decay)
    y = _rwkv7_scan(rh, dh, kh, vh, -kk, kk * ah)
    mu_y = jnp.mean(y, axis=-1, keepdims=True)
    var_y = jnp.mean(jnp.square(y - mu_y), axis=-1, keepdims=True)
    y = (y - mu_y) * lax.rsqrt(var_y + RW_LN_EPS)
    y = y.reshape(Bsz, T, BRANCH_WIDTH) * ln_g.astype(jnp.float32) + ln_b.astype(jnp.float32)
    bonus = jnp.sum(rh * kh * r_k.astype(jnp.float32), axis=-1, keepdims=True) * vh
    y = y + bonus.reshape(Bsz, T, BRANCH_WIDTH)
    return y.astype(dt) * g


def _conv_branch(p_cv, cv_w, cv_b, ln_g, ln_b):
    a, b = _split(p_cv, (CONV_CH, CONV_CH))
    u = a * jax.nn.sigmoid(b)
    u = lax.conv_general_dilated(
        u, cv_w[:, None, :], window_strides=(1,), padding=((CONV_WIDTH - 1, 0),),
        dimension_numbers=('NWC', 'WIO', 'NWC'), feature_group_count=CONV_CH) + cv_b
    u = _layer_norm(u, ln_g, ln_b)
    return jax.nn.silu(u)


def _gla_chunked(q, k, v, log_a):
    Bsz, T, H, dk = q.shape
    dv = v.shape[-1]
    L = GLA_CHUNK
    n = T // L
    to_chunks = lambda t: t.reshape(Bsz, n, L, H, t.shape[-1]).transpose(1, 0, 3, 2, 4)
    q, k, v, log_a = (to_chunks(t) for t in (q, k, v, log_a))
    b = jnp.cumsum(log_a, axis=-2)
    b_last = b[..., -1:, :]
    q_dec = q * jnp.exp(b)
    k_inv = k * jnp.exp(-b)
    k_end = k * jnp.exp(b_last - b)
    mask = jnp.tril(jnp.ones((L, L), dtype=bool))
    scores = jnp.where(mask, jnp.einsum('nbhtd,nbhsd->nbhts', q_dec, k_inv), 0.0)
    o_intra = jnp.einsum('nbhts,nbhsv->nbhtv', scores, v)

    def step(S, inp):
        qd, ke, vc, bl = inp
        o = jnp.einsum('bhtd,bhdv->bhtv', qd, S)
        S = S * jnp.exp(bl[:, :, 0, :])[..., None] + jnp.einsum('bhsd,bhsv->bhdv', ke, vc)
        return S, o

    S0 = jnp.zeros((Bsz, H, dk, dv), jnp.float32)
    _, o_inter = lax.scan(step, S0, (q_dec, k_end, v, b_last))
    o = o_intra + o_inter
    return o.transpose(1, 0, 3, 2, 4).reshape(Bsz, T, H, dv)


def _gla_branch(g_q, g_k, g_v, g_r, g_z, a2, ab, ln_g):
    Bsz, T, _ = g_q.shape
    dt = g_q.dtype
    log_a = jax.nn.log_sigmoid((g_z @ a2 + ab).astype(jnp.float32)) / GLA_TAU
    q = g_q.astype(jnp.float32).reshape(Bsz, T, GLA_HEADS, GLA_DK) * (GLA_DK ** -0.5)
    k = g_k.astype(jnp.float32).reshape(Bsz, T, GLA_HEADS, GLA_DK)
    v = g_v.astype(jnp.float32).reshape(Bsz, T, GLA_HEADS, GLA_DV)
    o = _gla_chunked(q, k, v, log_a.reshape(Bsz, T, GLA_HEADS, GLA_DK))
    o = o * lax.rsqrt(jnp.mean(o * o, axis=-1, keepdims=True) + GLA_EPS)
    o = o.reshape(Bsz, T, GLA_HEADS * GLA_DV).astype(dt) * ln_g
    return o * jax.nn.silu(g_r)


def _fox_branch(f_q, f_k, f_v, f_z, bf):
    Bsz, T, _ = f_q.shape
    heads = lambda t: t.reshape(Bsz, T, FOX_HEADS, FOX_HEAD_DIM).transpose(0, 2, 1, 3)
    qh = heads(f_q) * (FOX_HEAD_DIM ** -0.5)
    kh, vh = heads(f_k), heads(f_v)
    log_f = jax.nn.log_sigmoid((f_z + bf).astype(jnp.float32))
    c = jnp.cumsum(log_f, axis=1).transpose(0, 2, 1)
    diag = jnp.tril(jnp.ones((FOX_BLOCK, FOX_BLOCK), dtype=bool))
    outs = []
    for i in range(T // FOX_BLOCK):
        q0, q1 = i * FOX_BLOCK, (i + 1) * FOX_BLOCK
        logits = jnp.einsum('bhtd,bhsd->bhts', qh[:, :, q0:q1], kh[:, :, :q1]).astype(jnp.float32)
        logits = logits + c[:, :, q0:q1, None] - c[:, :, None, :q1]
        mask = jnp.concatenate([jnp.ones((FOX_BLOCK, q0), dtype=bool), diag], axis=1)
        probs = jax.nn.softmax(jnp.where(mask, logits, -jnp.inf), axis=-1).astype(vh.dtype)
        outs.append(jnp.einsum('bhts,bhsd->bhtd', probs, vh[:, :, :q1]))
    o = jnp.concatenate(outs, axis=2)
    return o.transpose(0, 2, 1, 3).reshape(Bsz, T, FOX_HEADS * FOX_HEAD_DIM)


def _cross_attention(x, mem, wq, wk, wv, wo):
    Bsz, T, D = x.shape
    M = mem.shape[1]
    q = (x @ wq).reshape(Bsz, T, XA_HEADS, XA_HEAD_DIM)
    k = (mem @ wk).reshape(Bsz, M, XA_HEADS, XA_HEAD_DIM)
    v = (mem @ wv).reshape(Bsz, M, XA_HEADS, XA_HEAD_DIM)
    s = jnp.einsum('bthd,bmhd->bhtm', q, k).astype(jnp.float32) * (XA_HEAD_DIM ** -0.5)
    p = jax.nn.softmax(s, axis=-1).astype(x.dtype)
    o = jnp.einsum('bhtm,bmhd->bthd', p, v).reshape(Bsz, T, D)
    return o @ wo


def _swiglu(x, w1, w3, w2):
    return (jax.nn.silu(x @ w1) * (x @ w3)) @ w2


def setup_inputs(seed: int = 0) -> dict:
    key = jax.random.key(seed)
    ks = iter(jax.random.split(key, 48))
    L, D = DEPTH, D_MODEL
    nrm = lambda shape, scale: jax.random.normal(next(ks), shape, jnp.float32) * scale
    return {
        "x": nrm((BATCH, SEQ, D), 1.0),
        "mem": nrm((BATCH, MEM_LEN, D), 1.0),
        "w_in": nrm((L, D, D_IN), D ** -0.5),
        "rw_mu": jax.random.uniform(next(ks), (L, RW_SHIFT_COLS), jnp.float32),
        "rw_w0": -1.0 + nrm((L, BRANCH_WIDTH), 0.5),
        "rw_w2": nrm((L, RW_DECAY_RANK, BRANCH_WIDTH), RW_DECAY_RANK ** -0.5),
        "rw_a0": nrm((L, BRANCH_WIDTH), 0.1),
        "rw_a2": nrm((L, RW_AAA_RANK, BRANCH_WIDTH), RW_AAA_RANK ** -0.5),
        "rw_g2": nrm((L, RW_GATE_RANK, BRANCH_WIDTH), RW_GATE_RANK ** -0.5),
        "rw_kk": 1.0 + nrm((L, BRANCH_WIDTH), 0.1),
        "rw_ka": 1.0 + nrm((L, BRANCH_WIDTH), 0.1),
        "rw_rk": nrm((L, RW_HEADS, RW_HEAD_DIM), 0.1),
        "rw_ln_g": 1.0 + nrm((L, BRANCH_WIDTH), 0.02),
        "rw_ln_b": nrm((L, BRANCH_WIDTH), 0.02),
        "rw_up": nrm((L, BRANCH_WIDTH, D), BRANCH_WIDTH ** -0.5),
        "cv_w": nrm((L, CONV_WIDTH, CONV_CH), CONV_WIDTH ** -0.5),
        "cv_b": nrm((L, CONV_CH), 0.02),
        "cv_ln_g": 1.0 + nrm((L, CONV_CH), 0.02),
        "cv_ln_b": nrm((L, CONV_CH), 0.02),
        "cv_up": nrm((L, CONV_CH, D), CONV_CH ** -0.5),
        "gla_a2": nrm((L, GLA_GATE_RANK, GLA_HEADS * GLA_DK), GLA_GATE_RANK ** -0.5),
        "gla_ab": nrm((L, GLA_HEADS * GLA_DK), 0.1),
        "gla_ln_g": 1.0 + nrm((L, GLA_HEADS * GLA_DV), 0.02),
        "gla_up": nrm((L, GLA_HEADS * GLA_DV, D), (GLA_HEADS * GLA_DV) ** -0.5),
        "fox_bf": 3.0 + nrm((L, FOX_HEADS), 0.5),
        "fox_up": nrm((L, FOX_HEADS * FOX_HEAD_DIM, D), (FOX_HEADS * FOX_HEAD_DIM) ** -0.5),
        "gate_b": nrm((L, N_BRANCH, D), 0.1),
        "w_out": nrm((L, D, D), BETA * D ** -0.5),
        "xa_wq": nrm((L, D, D), D ** -0.5),
        "xa_wk": nrm((L, D, D), D ** -0.5),
        "xa_wv": nrm((L, D, D), D ** -0.5),
        "xa_wo": nrm((L, D, D), BETA * D ** -0.5),
        "ffn_w1": nrm((L, D, D_FF), D ** -0.5),
        "ffn_w3": nrm((L, D, D_FF), D ** -0.5),
        "ffn_w2": nrm((L, D_FF, D), BETA * D_FF ** -0.5),
        "ln_g": 1.0 + nrm((L, 3, D), 0.02),
        "ln_b": nrm((L, 3, D), 0.02),
    }


def reference(x, mem, w_in, rw_mu, rw_w0, rw_w2, rw_a0, rw_a2, rw_g2, rw_kk, rw_ka, rw_rk,
              rw_ln_g, rw_ln_b, rw_up, cv_w, cv_b, cv_ln_g, cv_ln_b, cv_up, gla_a2, gla_ab,
              gla_ln_g, gla_up, fox_bf, fox_up, gate_b, w_out, xa_wq, xa_wk, xa_wv, xa_wo,
              ffn_w1, ffn_w3, ffn_w2, ln_g, ln_b):
    Bsz, T, D = x.shape
    for l in range(DEPTH):
        p = x @ w_in[l]
        (p_rw, p_cv, g_q, g_k, g_v, g_r, g_z,
         f_q, f_k, f_v, f_z, p_gate) = _split(p, COL_SIZES)
        u_rw = _rwkv7_branch(p_rw, rw_mu[l], rw_w0[l], rw_w2[l], rw_a0[l], rw_a2[l], rw_g2[l],
                             rw_kk[l], rw_ka[l], rw_rk[l], rw_ln_g[l], rw_ln_b[l]) @ rw_up[l]
        u_cv = _conv_branch(p_cv, cv_w[l], cv_b[l], cv_ln_g[l], cv_ln_b[l]) @ cv_up[l]
        u_gla = _gla_branch(g_q, g_k, g_v, g_r, g_z, gla_a2[l], gla_ab[l], gla_ln_g[l]) @ gla_up[l]
        u_fox = _fox_branch(f_q, f_k, f_v, f_z, fox_bf[l]) @ fox_up[l]
        gates = jax.nn.sigmoid(p_gate.reshape(Bsz, T, N_BRANCH, D) + gate_b[l])
        merged = (gates[:, :, 0] * u_rw + gates[:, :, 1] * u_cv
                  + gates[:, :, 2] * u_gla + gates[:, :, 3] * u_fox)
        x = _layer_norm(ALPHA * x + merged @ w_out[l], ln_g[l, 0], ln_b[l, 0])
        y = _cross_attention(x, mem, xa_wq[l], xa_wk[l], xa_wv[l], xa_wo[l])
        x = _layer_norm(ALPHA * x + y, ln_g[l, 1], ln_b[l, 1])
        y = _swiglu(x, ffn_w1[l], ffn_w3[l], ffn_w2[l])
        x = _layer_norm(ALPHA * x + y, ln_g[l, 2], ln_b[l, 2])
    return x
```

```cpp
#include <hip/hip_runtime.h>
#include <hip/hip_cooperative_groups.h>
#include <cstdio>
namespace cg = cooperative_groups;

#define LAS __attribute__((address_space(3)))
typedef unsigned short bf16_t;
typedef short bf16x8 __attribute__((ext_vector_type(8)));
typedef float f32x4 __attribute__((ext_vector_type(4)));
typedef unsigned u32x4 __attribute__((ext_vector_type(4)));
typedef unsigned u32x2 __attribute__((ext_vector_type(2)));

constexpr int NTOK = 16384, DM = 1024, SEQ = 2048, NB = 8, DEPTH = 4, DIN = 7220, PLD = 7424, DFF = 2816;
constexpr int C_RWR = 0, C_RWK = 256, C_RWV = 512, C_LORA = 768, C_CVA = 1056, C_CVB = 1312, C_GQ = 1568, C_GK = 1696, C_GV = 1824, C_GR = 2080,
              C_GZ = 2336, C_FQ = 2352, C_FK = 2608, C_FV = 2864, C_FZ = 3120, C_GATE = 3328;
constexpr float ALPHA = 1.681792830507429f;
constexpr float LN_EPS = 1e-5f;

constexpr size_t WS_WIN = 0;
constexpr size_t WS_UP = WS_WIN + (size_t)PLD * 1024 * 2;
constexpr size_t WS_WOUT = WS_UP + (size_t)4 * 1024 * 256 * 2;
constexpr size_t WS_WQ = WS_WOUT + (size_t)1024 * 1024 * 2;
constexpr size_t WS_WO = WS_WQ + (size_t)1024 * 1024 * 2;
constexpr size_t WS_FFU = WS_WO + (size_t)1024 * 1024 * 2;
constexpr size_t WS_FFD = WS_FFU + (size_t)5632 * 1024 * 2;
constexpr size_t WS_KV = WS_FFD + (size_t)1024 * DFF * 2;
constexpr size_t WS_XB = WS_KV + (size_t)2048 * 8192 * 2;
constexpr size_t WS_Y = WS_XB + (size_t)NTOK * 1024 * 2;
constexpr size_t WS_DEC = WS_Y + (size_t)4 * NTOK * 256 * 2;
constexpr size_t WS_R = WS_DEC + (size_t)NTOK * 256 * 4;
constexpr size_t WS_KM = WS_R + (size_t)NTOK * 256 * 2;
constexpr size_t WS_V = WS_KM + (size_t)NTOK * 256 * 2;
constexpr size_t WS_AN = WS_V + (size_t)NTOK * 256 * 2;
constexpr size_t WS_BN = WS_AN + (size_t)NTOK * 256 * 2;
constexpr size_t WS_CF = WS_BN + (size_t)NTOK * 256 * 2;
constexpr size_t WS_P = WS_CF + (size_t)NTOK * 4 * 4;
constexpr size_t WS_LORA = WS_P + (size_t)NTOK * PLD * 2;
constexpr size_t WS_BAR = WS_LORA + (size_t)256 * 288 * 2;
constexpr size_t WS_END = WS_BAR + 16384;
constexpr size_t XB_YRAW = 0, XB_G = (size_t)NTOK * 256 * 4, XB_BON = XB_G + (size_t)NTOK * 256 * 2;
constexpr size_t Y_MEMB = 0, Y_WKV = (size_t)2048 * 1024 * 2;
constexpr size_t P_Q = 0, P_O = (size_t)NTOK * 1024 * 2, P_H = (size_t)2 * NTOK * 1024 * 2;

constexpr int LDS_BYTES = 131072 + 16;

struct Params { const float* in[37]; float* out; unsigned char* ws; };

__device__ __forceinline__ float bf2f(bf16_t b) { return __uint_as_float(((unsigned)b) << 16); }
__device__ __forceinline__ float bflo(unsigned w) { return __uint_as_float(w << 16); }
__device__ __forceinline__ float bfhi(unsigned w) { return __uint_as_float(w & 0xffff0000u); }
__device__ __forceinline__ bf16_t f2bf(float f) { unsigned u = __float_as_uint(f); u += 0x7FFFu + ((u >> 16) & 1u); return (bf16_t)(u >> 16); }
__device__ __forceinline__ unsigned pack2(float lo, float hi) { return (unsigned)f2bf(lo) | ((unsigned)f2bf(hi) << 16); }
__device__ __forceinline__ float sigmoidf_(float x) { return 1.0f / (1.0f + __expf(-x)); }
__device__ __forceinline__ float siluf_(float x) { return x / (1.0f + __expf(-x)); }
__device__ __forceinline__ float logsigf_(float x) { return fminf(x, 0.f) - log1pf(__expf(-fabsf(x))); }
__device__ __forceinline__ float wsum64(float v) { v += __shfl_xor(v, 32); v += __shfl_xor(v, 16); v += __shfl_xor(v, 8); v += __shfl_xor(v, 4); v += __shfl_xor(v, 2); v += __shfl_xor(v, 1); return v; }
__device__ __forceinline__ float rsum16(float v) { v += __shfl_xor(v, 8); v += __shfl_xor(v, 4); v += __shfl_xor(v, 2); v += __shfl_xor(v, 1); return v; }

typedef float f32x2 __attribute__((ext_vector_type(2)));
template <int CTRL> __device__ __forceinline__ float dpp_mov(float x) { return __int_as_float(__builtin_amdgcn_update_dpp(0, __float_as_int(x), CTRL, 0xF, 0xF, true)); }
__device__ __forceinline__ float dsum16(float x) { x += dpp_mov<0xB1>(x); x += dpp_mov<0x4E>(x); x += dpp_mov<0x124>(x); x += dpp_mov<0x128>(x); return x; }
__device__ __forceinline__ float dsum8(float x) { x += dpp_mov<0xB1>(x); x += dpp_mov<0x4E>(x); x += dpp_mov<0x141>(x); return x; }
__device__ __forceinline__ int otid() { int t = threadIdx.x; asm volatile("" : "+v"(t)); return t; }


#define XB_TMO      128
#define XB_XCNT(j)  (256  + 64 * (j))
#define XB_XSUB(j)  (1280 + 64 * (j))
#define XB_XGEN(j)  (2304 + 64 * (j))
#define XB_TOP      3328
#define XB_TOPGEN   3392
#define XCD_BAR_WORDS 3456
#define XB_SPIN_CAP (1u << 18)
__device__ __forceinline__ unsigned xb_ld(unsigned* p)              { return __hip_atomic_load(p, __ATOMIC_RELAXED, __HIP_MEMORY_SCOPE_AGENT); }
__device__ __forceinline__ unsigned xb_add(unsigned* p, unsigned v) { return __hip_atomic_fetch_add(p, v, __ATOMIC_RELAXED, __HIP_MEMORY_SCOPE_AGENT); }
__device__ __forceinline__ unsigned xb_xcc_id() { return (unsigned)__builtin_amdgcn_s_getreg((3 << 11) | 20) & 0xFu; }
#define XB_SPIN(cond, bar) do { unsigned _sp = 0; while (cond) { __builtin_amdgcn_s_sleep(1); \
    if ((++_sp & 255u) == 0u) { if (xb_ld(&(bar)[XB_TMO])) break; if (_sp > XB_SPIN_CAP) { atomicAdd(&(bar)[XB_TMO], 1u); break; } } } } while (0)
struct XcdBarrier { unsigned* bar; unsigned x; volatile LAS unsigned* st; };
__device__ __forceinline__ XcdBarrier xcd_barrier_post(unsigned* bar, volatile LAS unsigned* st) {
    XcdBarrier b; b.bar = bar; b.x = xb_xcc_id(); b.st = st;
    if (threadIdx.x == 0) (void)xb_add(&bar[XB_XCNT(b.x)], 1u);
    return b;
}
__device__ __forceinline__ void xcd_barrier_complete(unsigned* bar, unsigned x, unsigned& nloc, unsigned& nx) {
    const unsigned G = gridDim.x * gridDim.y * gridDim.z;
    unsigned sum, cnt, mine, sp = 0u;
    for (;;) {
        sum = 0u; cnt = 0u; mine = 0u;
#pragma unroll
        for (unsigned j = 0; j < 16; ++j) { const unsigned c = xb_ld(&bar[XB_XCNT(j)]); sum += c; cnt += (c > 0u) ? 1u : 0u; mine = (j == x) ? c : mine; }
        if (sum == G) break;
        __builtin_amdgcn_s_sleep(1);
        if ((++sp & 255u) == 0u) { if (xb_ld(&bar[XB_TMO])) break; if (sp > XB_SPIN_CAP) { atomicAdd(&bar[XB_TMO], 1u); break; } }
    }
    nloc = mine > 0u ? mine : 1u; nx = cnt > 0u ? cnt : 1u;
}
__device__ __forceinline__ void xcd_barrier(const XcdBarrier& b) {
    asm volatile("s_waitcnt vmcnt(0)" ::: "memory");
    __syncthreads();
    if (threadIdx.x == 0) {
        unsigned* bar = b.bar;
        __builtin_amdgcn_s_waitcnt(0);
        unsigned nloc = b.st[0], nx = b.st[1];
        if (nloc == 0u) { xcd_barrier_complete(bar, b.x, nloc, nx); b.st[0] = nloc; b.st[1] = nx; }
        const unsigned old = xb_add(&bar[XB_XSUB(b.x)], 1u);
        const unsigned gen = old / nloc;
        if (old + 1u == (gen + 1u) * nloc) {
            __builtin_amdgcn_fence(__ATOMIC_RELEASE, "agent");
            asm volatile("s_waitcnt vmcnt(0)" ::: "memory");
            const unsigned og = xb_add(&bar[XB_TOP], 1u);
            const unsigned tg = og / nx;
            if (og + 1u == (tg + 1u) * nx) xb_add(&bar[XB_TOPGEN], 1u);
            else XB_SPIN(xb_ld(&bar[XB_TOPGEN]) == tg, bar);
            __builtin_amdgcn_fence(__ATOMIC_ACQUIRE, "agent");
            xb_add(&bar[XB_XGEN(b.x)], 1u);
            asm volatile("s_waitcnt vmcnt(0)" ::: "memory");
        } else {
            XB_SPIN(xb_ld(&bar[XB_XGEN(b.x)]) == gen, bar);
            __builtin_amdgcn_fence(__ATOMIC_ACQUIRE, "agent");
            asm volatile("s_waitcnt vmcnt(0)" ::: "memory");
        }
    }
    __syncthreads();
}

namespace pg8 {
constexpr int BM = 256, BK = 64, HALF = 128, HTB = HALF * BK * 2, NXCD = 8, WGM = 8;
__device__ __forceinline__ int lds_byte(int r, int c) { const int st = (r >> 4) * 2 + (c >> 5), rr = r & 15, cc = c & 31, ob = rr * 64 + cc * 2; return st * 1024 + (ob ^ (((ob >> 9) & 1) << 5)); }
__device__ __forceinline__ void stage_rc(int b, int& R, int& C) { const int st = b / 1024, sb = b % 1024, swz = sb ^ (((sb >> 9) & 1) << 5); R = (st >> 1) * 16 + swz / 64; C = (st & 1) * 32 + (swz % 64) / 2; }
__device__ __forceinline__ int perm32(int rho) { const int n = rho >> 4, i = rho & 15; return 8 * (i >> 2) + 4 * n + (i & 3); }
struct Unit { int pm, pn; };
struct Gemm { const bf16_t* A; const bf16_t* Bt; int lda, ldb, K; };
struct StaticOrder {
    int nM, nN, nwg, G, c;
    __device__ __forceinline__ void init(int M, int N, int G_, int c_) { nM = M / BM; nN = N / BM; nwg = nM * nN; G = G_; c = c_; }
    __device__ __forceinline__ bool next(int i, Unit& u) const {
        const long L = (long)i * G + c; if (L >= nwg) return false;
        int wgid = (int)L; { const int q = nwg / NXCD, r = nwg % NXCD, xcd = wgid % NXCD, off = wgid / NXCD; wgid = (xcd < r ? xcd * (q + 1) : r * (q + 1) + (xcd - r) * q) + off; }
        const int nig = WGM * nN, gid = wgid / nig, fm = gid * WGM, gsz = WGM;
        u.pm = fm + ((wgid % nig) % gsz); u.pn = (wgid % nig) / gsz; return true;
    }
};
struct MergeOrder {
    StaticOrder so;
    __device__ __forceinline__ bool next(int i, Unit& u) const { Unit t; if (!so.next(i >> 2, t)) return false; const int br = i & 3; u.pm = br * 64 + t.pm; u.pn = br * 4 + t.pn; return true; }
};
__device__ __forceinline__ unsigned cvt_pk_bf16(float lo, float hi) { unsigned r; asm volatile("v_cvt_pk_bf16_f32 %0, %1, %2" : "=v"(r) : "v"(lo), "v"(hi)); return r; }

struct EpiStoreBf16 {
    static constexpr bool PERM = true;
    bf16_t* O; int ldc;
    __device__ __forceinline__ void operator()(const f32x4 (&acc)[2][2][4][2], const Unit& u, int wr, int wc, int fr, int fq) const {
        const int row0 = u.pm * BM + wr * 64 + fr, col0 = u.pn * BM + wc * 32 + 8 * fq;
#pragma unroll
        for (int ai = 0; ai < 2; ++ai)
#pragma unroll
            for (int m = 0; m < 4; ++m) { bf16_t* rowp = O + (size_t)(row0 + ai * HALF + m * 16) * ldc + col0;
#pragma unroll
                for (int bj = 0; bj < 2; ++bj) { const f32x4 v0 = acc[ai][bj][m][0], v1 = acc[ai][bj][m][1];
                    u32x4 w; w.x = cvt_pk_bf16(v0[0], v0[1]); w.y = cvt_pk_bf16(v0[2], v0[3]); w.z = cvt_pk_bf16(v1[0], v1[1]); w.w = cvt_pk_bf16(v1[2], v1[3]);
                    *(u32x4*)(rowp + bj * HALF) = w; } }
    }
};
struct EpiResid {
    static constexpr bool PERM = false;
    float* X;
    __device__ __forceinline__ void operator()(const f32x4 (&acc)[2][2][4][2], const Unit& u, int wr, int wc, int fr, int fq) const {
        const int row0 = u.pm * BM + wr * 64 + fr, col0 = u.pn * BM + wc * 32 + 4 * fq;
#pragma unroll
        for (int ai = 0; ai < 2; ++ai) {
            f32x4 xv[4][2][2];
#pragma unroll
            for (int m = 0; m < 4; ++m) { const float* rowp = X + (size_t)(row0 + ai * HALF + m * 16) * DM + col0;
#pragma unroll
                for (int bj = 0; bj < 2; ++bj)
#pragma unroll
                    for (int n = 0; n < 2; ++n) xv[m][bj][n] = *(const f32x4*)(rowp + bj * HALF + n * 16); }
#pragma unroll
            for (int m = 0; m < 4; ++m) { float* rowp = X + (size_t)(row0 + ai * HALF + m * 16) * DM + col0;
#pragma unroll
                for (int bj = 0; bj < 2; ++bj)
#pragma unroll
                    for (int n = 0; n < 2; ++n) *(f32x4*)(rowp + bj * HALF + n * 16) = xv[m][bj][n] * ALPHA + acc[ai][bj][m][n]; }
            asm volatile("" ::: "memory");
        }
    }
};
struct EpiSwiglu {
    static constexpr bool PERM = true;
    bf16_t* H;
    __device__ __forceinline__ void operator()(const f32x4 (&acc)[2][2][4][2], const Unit& u, int wr, int wc, int fr, int fq) const {
        const int row0 = u.pm * BM + wr * 64 + fr, col0 = u.pn * HALF + wc * 32 + 8 * fq;
#pragma unroll
        for (int ai = 0; ai < 2; ++ai)
#pragma unroll
            for (int m = 0; m < 4; ++m) { bf16_t* rowp = H + (size_t)(row0 + ai * HALF + m * 16) * DFF + col0;
                float h[8];
#pragma unroll
                for (int n = 0; n < 2; ++n)
#pragma unroll
                    for (int j = 0; j < 4; ++j) { const float a = acc[ai][0][m][n][j], b = acc[ai][1][m][n][j]; h[n * 4 + j] = siluf_(a) * b; }
                u32x4 w; w.x = cvt_pk_bf16(h[0], h[1]); w.y = cvt_pk_bf16(h[2], h[3]); w.z = cvt_pk_bf16(h[4], h[5]); w.w = cvt_pk_bf16(h[6], h[7]);
                *(u32x4*)rowp = w; }
    }
};
struct EpiMerge {
    static constexpr bool PERM = true;
    const bf16_t* P; const float* gate_b; bf16_t* Mg;
    __device__ __forceinline__ void operator()(const f32x4 (&acc)[2][2][4][2], const Unit& u, int wr, int wc, int fr, int fq) const {
        const int br = u.pm >> 6, pm = u.pm & 63, pn = u.pn & 3;
        const int row0 = pm * BM + wr * 64 + fr, col0 = pn * BM + wc * 32 + 8 * fq;
#pragma unroll
        for (int bj = 0; bj < 2; ++bj) { const int col = col0 + bj * HALF;
            const f32x4 gb0 = *(const f32x4*)(gate_b + br * 1024 + col), gb1 = *(const f32x4*)(gate_b + br * 1024 + col + 4);
#pragma unroll
            for (int ai = 0; ai < 2; ++ai) {
                u32x4 gw[4], ov[4];
#pragma unroll
                for (int m = 0; m < 4; ++m) { const size_t row = (size_t)(row0 + ai * HALF + m * 16);
                    gw[m] = *(const u32x4*)(P + row * PLD + C_GATE + br * 1024 + col);
                    ov[m] = (u32x4){0u, 0u, 0u, 0u}; if (br > 0) ov[m] = *(const u32x4*)(Mg + row * DM + col); }
#pragma unroll
                for (int m = 0; m < 4; ++m) { const size_t row = (size_t)(row0 + ai * HALF + m * 16); const u32x4 g4 = gw[m], o = ov[m];
                    float v[8];
                    v[0] = sigmoidf_(bflo(g4.x) + gb0[0]) * acc[ai][bj][m][0][0] + bflo(o.x); v[1] = sigmoidf_(bfhi(g4.x) + gb0[1]) * acc[ai][bj][m][0][1] + bfhi(o.x);
                    v[2] = sigmoidf_(bflo(g4.y) + gb0[2]) * acc[ai][bj][m][0][2] + bflo(o.y); v[3] = sigmoidf_(bfhi(g4.y) + gb0[3]) * acc[ai][bj][m][0][3] + bfhi(o.y);
                    v[4] = sigmoidf_(bflo(g4.z) + gb1[0]) * acc[ai][bj][m][1][0] + bflo(o.z); v[5] = sigmoidf_(bfhi(g4.z) + gb1[1]) * acc[ai][bj][m][1][1] + bfhi(o.z);
                    v[6] = sigmoidf_(bflo(g4.w) + gb1[2]) * acc[ai][bj][m][1][2] + bflo(o.w); v[7] = sigmoidf_(bfhi(g4.w) + gb1[3]) * acc[ai][bj][m][1][3] + bfhi(o.w);
                    u32x4 w; w.x = cvt_pk_bf16(v[0], v[1]); w.y = cvt_pk_bf16(v[2], v[3]); w.z = cvt_pk_bf16(v[4], v[5]); w.w = cvt_pk_bf16(v[6], v[7]);
                    *(u32x4*)(Mg + row * DM + col) = w; }
                asm volatile("" ::: "memory"); }
            asm volatile("" ::: "memory"); }
    }
};

template <class Epi, class Sched>
__device__ __forceinline__ void gemm_phase(LAS unsigned char* lds, const Gemm g, const Sched& S, const Epi& E) {
    const int tid = otid(), wid = __builtin_amdgcn_readfirstlane(tid >> 6), lane = tid & 63, wr = wid >> 2, wc = wid & 3, fr = lane & 15, fq = lane >> 4;
    const int K = g.K, nt = K / BK;
    unsigned voffA[2], voffB[2];
#pragma unroll
    for (int i = 0; i < 2; ++i) { int R, C; stage_rc(tid * 16 + i * 8192, R, C); const int Rb = Epi::PERM ? ((R & ~31) + perm32(R & 31)) : R;
        voffA[i] = (unsigned)(R * g.lda + C) * 2u; voffB[i] = (unsigned)(Rb * g.ldb + C) * 2u; }
    const size_t kstep = (size_t)(BK * 2);
    const size_t hstepA = (size_t)HALF * g.lda * 2, hstepB = (size_t)HALF * g.ldb * 2;
    const size_t tstepA = 2 * hstepA, tstepB = 2 * hstepB;
    const unsigned ldsw = (unsigned)wid * 1024u;
    const int aoff = lds_byte(wr * 64 + fr, fq * 8), boff = lds_byte(wc * 32 + fr, fq * 8);
#define PG8_SA(b, h) (((b) * 2 + (h)) * HTB)
#define PG8_SB(b, h) ((4 + (b) * 2 + (h)) * HTB)
#define PG8_STAGE(bufoff, gbase, voff) do { _Pragma("unroll") for (int _i = 0; _i < 2; ++_i) \
        __builtin_amdgcn_global_load_lds((const unsigned*)((const char*)(gbase) + (voff)[_i]), (LAS unsigned*)(lds + (bufoff) + ldsw + _i * 8192), 16, 0, 0); } while (0)
#define PG8_LDA(dst, b, h) do { _Pragma("unroll") for (int m = 0; m < 4; ++m) _Pragma("unroll") for (int k = 0; k < 2; ++k) dst[m][k] = *(const LAS bf16x8*)(lds + PG8_SA(b, h) + aoff + m * 2048 + k * 1024); } while (0)
#define PG8_LDB(dst, b, h) do { _Pragma("unroll") for (int n = 0; n < 2; ++n) _Pragma("unroll") for (int k = 0; k < 2; ++k) dst[n][k] = *(const LAS bf16x8*)(lds + PG8_SB(b, h) + boff + n * 2048 + k * 1024); } while (0)
#define PG8_MMA(ai, bj, At, Bt) do { __builtin_amdgcn_s_setprio(1); _Pragma("unroll") for (int m = 0; m < 4; ++m) _Pragma("unroll") for (int n = 0; n < 2; ++n) _Pragma("unroll") for (int k = 0; k < 2; ++k) \
        acc[ai][bj][m][n] = __builtin_amdgcn_mfma_f32_16x16x32_bf16(Bt[n][k], At[m][k], acc[ai][bj][m][n], 0, 0, 0); __builtin_amdgcn_s_setprio(0); } while (0)
#define PG8_WAIT_V(n) asm volatile("s_waitcnt vmcnt(" #n ")" ::: "memory")
#define PG8_WAIT_L(n) asm volatile("s_waitcnt lgkmcnt(" #n ")" ::: "memory")
#define PG8_BAR __builtin_amdgcn_s_barrier()
#define PG8_SCHED __builtin_amdgcn_sched_barrier(0)
    Unit cur, nxt; int ui = 0;
    if (!S.next(0, cur)) return;
    f32x4 acc[2][2][4][2];
#pragma unroll
    for (int a = 0; a < 2; ++a)
#pragma unroll
        for (int b = 0; b < 2; ++b)
#pragma unroll
            for (int m = 0; m < 4; ++m)
#pragma unroll
                for (int n = 0; n < 2; ++n) acc[a][b][m][n] = (f32x4){0.f, 0.f, 0.f, 0.f};
    bf16x8 At[4][2], B0[2][2], B1[2][2];
    const char* cA = (const char*)g.A + (size_t)cur.pm * tstepA; const char* cB = (const char*)g.Bt + (size_t)cur.pn * tstepB;
    PG8_STAGE(PG8_SB(0, 0), cB, voffB); PG8_STAGE(PG8_SA(0, 0), cA, voffA); PG8_STAGE(PG8_SB(0, 1), cB + hstepB, voffB); PG8_STAGE(PG8_SA(0, 1), cA + hstepA, voffA);
    if (wr == 1) PG8_BAR;
    PG8_WAIT_V(4); PG8_BAR;
    PG8_STAGE(PG8_SB(1, 0), cB + kstep, voffB); PG8_STAGE(PG8_SA(1, 0), cA + kstep, voffA); PG8_STAGE(PG8_SB(1, 1), cB + hstepB + kstep, voffB);
    PG8_WAIT_V(6); PG8_BAR;
    for (;;) {
        const bool has_next = S.next(ui + 1, nxt);
        const char* nA = has_next ? (const char*)g.A + (size_t)nxt.pm * tstepA : cA; const char* nB = has_next ? (const char*)g.Bt + (size_t)nxt.pn * tstepB : cB;
#pragma unroll 1
        for (int t = 0; t < nt; t += 2) {
            const bool last = (t == nt - 2);
            const char* a1 = cA + (size_t)(t + 1) * kstep;
            const char* a2 = last ? nA : cA + (size_t)(t + 2) * kstep; const char* b2 = last ? nB : cB + (size_t)(t + 2) * kstep;
            const char* a3 = a2 + kstep; const char* b3 = b2 + kstep;
            PG8_LDB(B0, 0, 0); PG8_SCHED; PG8_LDA(At, 0, 0); PG8_STAGE(PG8_SA(1, 1), a1 + hstepA, voffA);
            PG8_WAIT_L(8); PG8_BAR; PG8_WAIT_L(0); PG8_MMA(0, 0, At, B0); PG8_BAR; PG8_SCHED;
            PG8_LDB(B1, 0, 1); PG8_STAGE(PG8_SB(0, 0), b2, voffB);
            PG8_BAR; PG8_WAIT_L(0); PG8_MMA(0, 1, At, B1); PG8_BAR;
            PG8_LDA(At, 0, 1); PG8_STAGE(PG8_SA(0, 0), a2, voffA);
            PG8_BAR; PG8_WAIT_L(0); PG8_MMA(1, 0, At, B0); PG8_BAR; PG8_SCHED;
            PG8_STAGE(PG8_SB(0, 1), b2 + hstepB, voffB);
            PG8_WAIT_V(6); PG8_BAR; PG8_MMA(1, 1, At, B1); PG8_BAR;
            PG8_LDB(B0, 1, 0); PG8_SCHED; PG8_LDA(At, 1, 0); PG8_STAGE(PG8_SA(0, 1), a2 + hstepA, voffA);
            PG8_WAIT_L(8); PG8_BAR; PG8_WAIT_L(0); PG8_MMA(0, 0, At, B0); PG8_BAR; PG8_SCHED;
            PG8_LDB(B1, 1, 1); PG8_STAGE(PG8_SB(1, 0), b3, voffB);
            PG8_BAR; PG8_WAIT_L(0); PG8_MMA(0, 1, At, B1); PG8_BAR;
            PG8_LDA(At, 1, 1); PG8_STAGE(PG8_SA(1, 0), a3, voffA);
            PG8_BAR; PG8_WAIT_L(0); PG8_MMA(1, 0, At, B0); PG8_BAR; PG8_SCHED;
            PG8_STAGE(PG8_SB(1, 1), b3 + hstepB, voffB);
            PG8_WAIT_V(6); PG8_BAR; PG8_MMA(1, 1, At, B1); PG8_BAR;
        }
        E(acc, cur, wr, wc, fr, fq);
        if (!has_next) break;
#pragma unroll
        for (int a = 0; a < 2; ++a)
#pragma unroll
            for (int b = 0; b < 2; ++b)
#pragma unroll
                for (int m = 0; m < 4; ++m)
#pragma unroll
                    for (int n = 0; n < 2; ++n) acc[a][b][m][n] = (f32x4){0.f, 0.f, 0.f, 0.f};
        cur = nxt; cA = nA; cB = nB; ++ui;
    }
    PG8_WAIT_V(0);
    if (wr == 0) PG8_BAR;
    PG8_BAR;
#undef PG8_SA
#undef PG8_SB
#undef PG8_STAGE
#undef PG8_LDA
#undef PG8_LDB
#undef PG8_MMA
#undef PG8_WAIT_V
#undef PG8_WAIT_L
#undef PG8_BAR
#undef PG8_SCHED
}
}

__device__ __forceinline__ void tconv_tile(LAS float* tile, const float* src, int ldS, int sc0, int scLimit, bf16_t* dst, int ldD, int dr0, int k0) {
    const int tid = otid();
    { const int r = tid >> 4, c4 = (tid & 15) * 4;
#pragma unroll
      for (int h = 0; h < 2; ++h) { const int k = r + 32 * h; f32x4 v = (f32x4){0.f, 0.f, 0.f, 0.f};
          if (sc0 + c4 < scLimit) v = *(const f32x4*)(src + (size_t)(k0 + k) * ldS + sc0 + c4);
          tile[k * 65 + c4 + 0] = v[0]; tile[k * 65 + c4 + 1] = v[1]; tile[k * 65 + c4 + 2] = v[2]; tile[k * 65 + c4 + 3] = v[3]; } }
    __syncthreads();
    { const int n = tid >> 3, kc = (tid & 7) * 8; float e[8];
#pragma unroll
      for (int i = 0; i < 8; ++i) e[i] = tile[(kc + i) * 65 + n];
      u32x4 w; w.x = pack2(e[0], e[1]); w.y = pack2(e[2], e[3]); w.z = pack2(e[4], e[5]); w.w = pack2(e[6], e[7]);
      *(u32x4*)(dst + (size_t)(dr0 + n) * ldD + k0 + kc) = w; }
    __syncthreads();
}

typedef const float* const __attribute__((address_space(4)))* kin_t;
struct Ctx {
    kin_t kin; unsigned char* ws; float* X; LAS unsigned char* lds; int G, bid;
    __device__ __forceinline__ const float* in(int k) const { int z = k; asm volatile("" : "+s"(z)); return kin[z]; }
#define WSP(name, T, off) __device__ __forceinline__ T* name() const { return (T*)(ws + (off)); }
    WSP(WinT, bf16_t, WS_WIN) WSP(UpT, bf16_t, WS_UP) WSP(WoutT, bf16_t, WS_WOUT) WSP(WqT, bf16_t, WS_WQ) WSP(WoT, bf16_t, WS_WO)
    WSP(FfuT, bf16_t, WS_FFU) WSP(FfdT, bf16_t, WS_FFD) WSP(KV, bf16_t, WS_KV) WSP(XB, bf16_t, WS_XB) WSP(Y, bf16_t, WS_Y)
    WSP(R, bf16_t, WS_R) WSP(KM, bf16_t, WS_KM) WSP(V, bf16_t, WS_V) WSP(AN, bf16_t, WS_AN) WSP(BN, bf16_t, WS_BN)
    WSP(P, bf16_t, WS_P) WSP(Gg, bf16_t, WS_XB + XB_G) WSP(Qb, bf16_t, WS_P + P_Q) WSP(Ob, bf16_t, WS_P + P_O) WSP(Hb, bf16_t, WS_P + P_H)
    WSP(Memb, bf16_t, WS_Y + Y_MEMB) WSP(WkvT, bf16_t, WS_Y + Y_WKV)
    WSP(LoraT, bf16_t, WS_LORA)
    WSP(DEC, float, WS_DEC) WSP(CF, float, WS_CF) WSP(YRAW, float, WS_XB + XB_YRAW) WSP(BON, float, WS_XB + XB_BON)
#undef WSP
};

__device__ __forceinline__ void convert_layer(const Ctx& c, int l) {
    LAS float* tile = (LAS float*)c.lds;
    { const float* w2 = c.in(5) + (size_t)l * 64 * 256; const float* a2 = c.in(7) + (size_t)l * 64 * 256; const float* g2 = c.in(8) + (size_t)l * 160 * 256; bf16_t* LT = c.LoraT();
      for (int i = c.bid * 512 + otid(); i < 288 * 256; i += c.G * 512) { const int k = i >> 8, n = i & 255;
          const float v = k < 64 ? w2[k * 256 + n] : (k < 128 ? a2[(k - 64) * 256 + n] : g2[(k - 128) * 256 + n]); LT[n * 288 + k] = f2bf(v); } }
    for (int t = c.bid; t < 4992; t += c.G) {
        if (t < 1856) { const int nt = t % 116, kt = t / 116; const int n0 = nt * 64;
            const float* src = c.in(2) + (size_t)l * 1024 * DIN;
            if (n0 < C_GATE) tconv_tile(tile, src, DIN, n0, 3124, c.WinT(), 1024, n0, kt * 64);
            else tconv_tile(tile, src, DIN, n0 - 204, DIN, c.WinT(), 1024, n0, kt * 64);
        } else if (t < 2112) { const int q = t - 1856, br = q >> 6, r = q & 63, nt = r & 15, kt = r >> 4;
            const float* srcu = br == 0 ? c.in(14) : (br == 1 ? c.in(19) : (br == 2 ? c.in(23) : c.in(25)));
            tconv_tile(tile, srcu + (size_t)l * 256 * 1024, 1024, nt * 64, 1024, c.UpT() + (size_t)br * 1024 * 256, 256, nt * 64, kt * 64);
        } else if (t < 2880) { const int q = t - 2112, w = q >> 8, r = q & 255, nt = r & 15, kt = r >> 4;
            const float* srcw = w == 0 ? c.in(27) : (w == 1 ? c.in(28) : c.in(31)); bf16_t* dst = w == 0 ? c.WoutT() : (w == 1 ? c.WqT() : c.WoT());
            tconv_tile(tile, srcw + (size_t)l * 1024 * 1024, 1024, nt * 64, 1024, dst, 1024, nt * 64, kt * 64);
        } else if (t < 4288) { const int q = t - 2880, nt = q % 88, kt = q / 88; const int n0 = nt * 64, u = n0 >> 8, r = n0 & 255;
            const float* src = (r < 128 ? c.in(32) : c.in(33)) + (size_t)l * 1024 * DFF;
            tconv_tile(tile, src, DFF, u * 128 + (r & 127), DFF, c.FfuT(), 1024, n0, kt * 64);
        } else { const int q = t - 4288, nt = q & 15, kt = q >> 4;
            tconv_tile(tile, c.in(34) + (size_t)l * DFF * 1024, 1024, nt * 64, 1024, c.FfdT(), DFF, nt * 64, kt * 64);
        }
    }
}

__device__ __forceinline__ void prepass(const Ctx& c) {
    const int gtid = c.bid * 512 + otid(), gsz = c.G * 512;
    { const f32x4* xs = (const f32x4*)c.in(0); f32x4* xd = (f32x4*)c.X; u32x2* xb = (u32x2*)c.XB();
      for (int i = gtid; i < NTOK * DM / 4; i += gsz) { const f32x4 v = xs[i]; xd[i] = v; u32x2 w; w.x = pack2(v[0], v[1]); w.y = pack2(v[2], v[3]); xb[i] = w; } }
    { const f32x4* ms = (const f32x4*)c.in(1); u32x2* mb = (u32x2*)c.Memb();
      for (int i = gtid; i < 2048 * DM / 4; i += gsz) { const f32x4 v = ms[i]; u32x2 w; w.x = pack2(v[0], v[1]); w.y = pack2(v[2], v[3]); mb[i] = w; } }
    LAS float* tile = (LAS float*)c.lds;
    for (int t = c.bid; t < 2048; t += c.G) {
        const int lw = t >> 8, r = t & 255, nt = r & 15, kt = r >> 4; const int l = lw >> 1, which = lw & 1;
        tconv_tile(tile, (which ? c.in(30) : c.in(29)) + (size_t)l * 1024 * 1024, 1024, nt * 64, 1024, c.WkvT(), 1024, lw * 1024 + nt * 64, kt * 64);
    }
    convert_layer(c, 0);
}

__device__ __forceinline__ void rw_prep_tile(const Ctx& c, int l, int tile) {
    const int tid = otid(), lane = tid & 63, wave = tid >> 6, r = lane & 15, g = lane >> 4;
    const int tok0 = tile * 64;
    LAS bf16_t* lin = (LAS bf16_t*)c.lds;
    const float* mu = c.in(3) + l * 1056;
    const bf16_t* P = c.P();
#pragma unroll
    for (int q = 0; q < 5; ++q) {
        const int pc = tid + 512 * q;
        if (pc < 64 * 36) {
            const int tk = pc / 36, j8 = pc - tk * 36; const int tok = tok0 + tk, col = C_LORA + j8 * 8;
            const u32x4 cu = *(const u32x4*)(P + (size_t)tok * PLD + col);
            u32x4 pr = (u32x4){0u, 0u, 0u, 0u}; if ((tok & (SEQ - 1)) != 0) pr = *(const u32x4*)(P + (size_t)(tok - 1) * PLD + col);
            const f32x4 m0 = *(const f32x4*)(mu + col), m1 = *(const f32x4*)(mu + col + 4);
            float v[8];
            v[0] = bflo(cu.x) + (bflo(pr.x) - bflo(cu.x)) * m0[0]; v[1] = bfhi(cu.x) + (bfhi(pr.x) - bfhi(cu.x)) * m0[1];
            v[2] = bflo(cu.y) + (bflo(pr.y) - bflo(cu.y)) * m0[2]; v[3] = bfhi(cu.y) + (bfhi(pr.y) - bfhi(cu.y)) * m0[3];
            v[4] = bflo(cu.z) + (bflo(pr.z) - bflo(cu.z)) * m1[0]; v[5] = bfhi(cu.z) + (bfhi(pr.z) - bfhi(cu.z)) * m1[1];
            v[6] = bflo(cu.w) + (bflo(pr.w) - bflo(cu.w)) * m1[2]; v[7] = bfhi(cu.w) + (bfhi(pr.w) - bfhi(cu.w)) * m1[3];
            if (j8 < 8) {
#pragma unroll
                for (int i = 0; i < 8; ++i) { const float e2 = __expf(2.f * v[i]); v[i] = 1.f - 2.f / (e2 + 1.f); }
            } else if (j8 >= 16) {
#pragma unroll
                for (int i = 0; i < 8; ++i) v[i] = sigmoidf_(v[i]);
            }
            u32x4 w; w.x = pack2(v[0], v[1]); w.y = pack2(v[2], v[3]); w.z = pack2(v[4], v[5]); w.w = pack2(v[6], v[7]);
            *(LAS u32x4*)(lin + tk * 296 + j8 * 8) = w;
        }
    }
    __syncthreads();
    const int h = wave & 3, th = wave >> 2;
    const bf16_t* LT = c.LoraT();
    f32x4 accW[2][4], accA[2][4], accG[2][4];
#pragma unroll
    for (int mt = 0; mt < 2; ++mt)
#pragma unroll
        for (int nt = 0; nt < 4; ++nt) { accW[mt][nt] = (f32x4){0.f, 0.f, 0.f, 0.f}; accA[mt][nt] = (f32x4){0.f, 0.f, 0.f, 0.f}; accG[mt][nt] = (f32x4){0.f, 0.f, 0.f, 0.f}; }
#pragma unroll
    for (int ks = 0; ks < 9; ++ks) {
        bf16x8 af[2];
#pragma unroll
        for (int mt = 0; mt < 2; ++mt) af[mt] = *(const LAS bf16x8*)(lin + (th * 32 + mt * 16 + r) * 296 + ks * 32 + 8 * g);
#pragma unroll
        for (int nt = 0; nt < 4; ++nt) {
            const int n = h * 64 + nt * 16 + r;
            const bf16x8 bfr = *(const bf16x8*)(LT + n * 288 + ks * 32 + 8 * g);
#pragma unroll
            for (int mt = 0; mt < 2; ++mt) {
                if (ks < 2) accW[mt][nt] = __builtin_amdgcn_mfma_f32_16x16x32_bf16(af[mt], bfr, accW[mt][nt], 0, 0, 0);
                else if (ks < 4) accA[mt][nt] = __builtin_amdgcn_mfma_f32_16x16x32_bf16(af[mt], bfr, accA[mt][nt], 0, 0, 0);
                else accG[mt][nt] = __builtin_amdgcn_mfma_f32_16x16x32_bf16(af[mt], bfr, accG[mt][nt], 0, 0, 0);
            }
        }
    }
    const float* w0 = c.in(4) + l * 256; const float* a0 = c.in(6) + l * 256; const float* kkp = c.in(9) + l * 256; const float* kap = c.in(10) + l * 256; const float* rkp = c.in(11) + l * 256;
    float w0v[4], a0v[4], kkv[4], kav[4], rkv[4], mur[4], muk[4], muv[4];
#pragma unroll
    for (int nt = 0; nt < 4; ++nt) { const int n = h * 64 + nt * 16 + r; w0v[nt] = w0[n]; a0v[nt] = a0[n]; kkv[nt] = kkp[n]; kav[nt] = kap[n]; rkv[nt] = rkp[n]; mur[nt] = mu[C_RWR + n]; muk[nt] = mu[C_RWK + n]; muv[nt] = mu[C_RWV + n]; }
#pragma unroll
    for (int mt = 0; mt < 2; ++mt)
#pragma unroll
        for (int reg = 0; reg < 4; ++reg) {
            const int tok = tok0 + th * 32 + mt * 16 + 4 * g + reg; const bool first = (tok & (SEQ - 1)) == 0;
            const bf16_t* pc = P + (size_t)tok * PLD; const bf16_t* pp = pc - PLD;
            float ssk = 0.f, bon = 0.f, kkn[4], av[4];
#pragma unroll
            for (int nt = 0; nt < 4; ++nt) {
                const int n = h * 64 + nt * 16 + r;
                const float cr = bf2f(pc[C_RWR + n]), ck = bf2f(pc[C_RWK + n]), cv = bf2f(pc[C_RWV + n]);
                const float qr = first ? 0.f : bf2f(pp[C_RWR + n]), qk = first ? 0.f : bf2f(pp[C_RWK + n]), qv = first ? 0.f : bf2f(pp[C_RWV + n]);
                const float rr = cr + (qr - cr) * mur[nt], kx = ck + (qk - ck) * muk[nt], vx = cv + (qv - cv) * muv[nt];
                const float pre = w0v[nt] + accW[mt][nt][reg];
                const float wlog = logsigf_(pre) - 0.5f;
                const float dec = __expf(-__expf(wlog));
                const float a = sigmoidf_(a0v[nt] + accA[mt][nt][reg]);
                const float kk_ = kx * kkv[nt]; ssk += kk_ * kk_;
                const float km = kx * (1.f + (a - 1.f) * kav[nt]);
                bon += rr * km * rkv[nt];
                const size_t o = (size_t)tok * 256 + n;
                c.DEC()[o] = dec; c.R()[o] = f2bf(rr); c.KM()[o] = f2bf(km); c.V()[o] = f2bf(vx); c.Gg()[o] = f2bf(accG[mt][nt][reg]);
                kkn[nt] = kk_; av[nt] = a;
            }
            ssk = rsum16(ssk); bon = rsum16(bon);
            const float inv = 1.f / fmaxf(sqrtf(ssk), 1e-12f);
#pragma unroll
            for (int nt = 0; nt < 4; ++nt) { const size_t o = (size_t)tok * 256 + h * 64 + nt * 16 + r; const float kn = kkn[nt] * inv; c.AN()[o] = f2bf(-kn); c.BN()[o] = f2bf(kn * av[nt]); }
            if (r == 0) c.BON()[(size_t)tok * 4 + h] = bon;
        }
    __syncthreads();
}

__device__ __forceinline__ void conv_tile(const Ctx& c, int l, int tile) {
    const int tid = otid(), lane = tid & 63, wave = tid >> 6;
    const int tok0 = tile * 32, t0 = tok0 & (SEQ - 1);
    LAS float* ub = (LAS float*)c.lds;
    LAS float* ob = ub + 62 * 256;
    const bf16_t* P = c.P();
#pragma unroll
    for (int q = 0; q < 4; ++q) {
        const int pc = tid + 512 * q;
        if (pc < 62 * 32) {
            const int row = pc >> 5, c8 = (pc & 31) * 8;
            f32x4 o0 = (f32x4){0.f, 0.f, 0.f, 0.f}, o1 = (f32x4){0.f, 0.f, 0.f, 0.f};
            if (t0 - 30 + row >= 0) { const size_t tok = (size_t)(tok0 - 30 + row);
                const u32x4 a = *(const u32x4*)(P + tok * PLD + C_CVA + c8), b = *(const u32x4*)(P + tok * PLD + C_CVB + c8);
                o0[0] = bflo(a.x) * sigmoidf_(bflo(b.x)); o0[1] = bfhi(a.x) * sigmoidf_(bfhi(b.x)); o0[2] = bflo(a.y) * sigmoidf_(bflo(b.y)); o0[3] = bfhi(a.y) * sigmoidf_(bfhi(b.y));
                o1[0] = bflo(a.z) * sigmoidf_(bflo(b.z)); o1[1] = bfhi(a.z) * sigmoidf_(bfhi(b.z)); o1[2] = bflo(a.w) * sigmoidf_(bflo(b.w)); o1[3] = bfhi(a.w) * sigmoidf_(bfhi(b.w)); }
            *(LAS f32x4*)(ub + row * 256 + c8) = o0; *(LAS f32x4*)(ub + row * 256 + c8 + 4) = o1;
        }
    }
    __syncthreads();
    { const int ch = tid & 255, tg = tid >> 8;
      const float* cw_ = c.in(15) + (size_t)l * 31 * 256; float cw[31];
#pragma unroll
      for (int w = 0; w < 31; ++w) cw[w] = cw_[w * 256 + ch];
      const float bias = c.in(16)[l * 256 + ch];
      for (int tt = 0; tt < 16; ++tt) { const int tl = tg * 16 + tt; float acc = bias;
#pragma unroll
          for (int w = 0; w < 31; ++w) acc += ub[(tl + w) * 256 + ch] * cw[w];
          ob[tl * 256 + ch] = acc; } }
    __syncthreads();
    { const f32x4 gv = *(const f32x4*)(c.in(17) + l * 256 + 4 * lane), bv = *(const f32x4*)(c.in(18) + l * 256 + 4 * lane);
      bf16_t* Yc = c.Y() + (size_t)1 * NTOK * 256;
      for (int q = 0; q < 4; ++q) { const int tl = wave * 4 + q;
          const f32x4 x = *(const LAS f32x4*)(ob + tl * 256 + 4 * lane);
          const float mean = wsum64((x[0] + x[1]) + (x[2] + x[3])) * (1.f / 256.f);
          const f32x4 d = x - mean;
          const float var = wsum64((d[0] * d[0] + d[1] * d[1]) + (d[2] * d[2] + d[3] * d[3])) * (1.f / 256.f);
          const float rstd = rsqrtf(var + LN_EPS);
          f32x4 y = d * rstd * gv + bv;
          u32x2 w; w.x = pack2(siluf_(y[0]), siluf_(y[1])); w.y = pack2(siluf_(y[2]), siluf_(y[3]));
          *(u32x2*)(Yc + (size_t)(tok0 + tl) * 256 + 4 * lane) = w; } }
    __syncthreads();
}

__device__ __forceinline__ void fox_cumsum(const Ctx& c, int l, int b) {
    const int tid = otid(), lane = tid & 63, wave = tid >> 6;
    LAS float* wt = (LAS float*)c.lds;
    const f32x4 bf = *(const f32x4*)(c.in(24) + l * 4);
    f32x4 pre[4]; f32x4 run = (f32x4){0.f, 0.f, 0.f, 0.f};
#pragma unroll
    for (int i = 0; i < 4; ++i) { const size_t tok = (size_t)b * SEQ + tid * 4 + i; const u32x2 z = *(const u32x2*)(c.P() + tok * PLD + C_FZ);
        run[0] += logsigf_(bflo(z.x) + bf[0]); run[1] += logsigf_(bfhi(z.x) + bf[1]); run[2] += logsigf_(bflo(z.y) + bf[2]); run[3] += logsigf_(bfhi(z.y) + bf[3]); pre[i] = run; }
    f32x4 inc = run;
#pragma unroll
    for (int off = 1; off < 64; off <<= 1) {
#pragma unroll
        for (int hh = 0; hh < 4; ++hh) { const float t = __shfl_up(inc[hh], off); if (lane >= off) inc[hh] += t; } }
    if (lane == 63) { wt[wave * 4 + 0] = inc[0]; wt[wave * 4 + 1] = inc[1]; wt[wave * 4 + 2] = inc[2]; wt[wave * 4 + 3] = inc[3]; }
    __syncthreads();
    f32x4 base = inc - run;
    for (int w = 0; w < wave; ++w) { base[0] += wt[w * 4 + 0]; base[1] += wt[w * 4 + 1]; base[2] += wt[w * 4 + 2]; base[3] += wt[w * 4 + 3]; }
#pragma unroll
    for (int i = 0; i < 4; ++i) { const size_t tok = (size_t)b * SEQ + tid * 4 + i; *(f32x4*)(c.CF() + tok * 4) = pre[i] + base; }
    __syncthreads();
}

__device__ __forceinline__ void rw_scan_item(const Ctx& c, int item) {
    const int tid = otid(), lane = tid & 63, wave = __builtin_amdgcn_readfirstlane(tid >> 6);
    const int qr = item & 3, h = (item >> 2) & 3, b = item >> 4;
    const int cb = h * 64, rb = qr * 16; const size_t tokb = (size_t)b * SEQ;
    LAS float* L = (LAS float*)c.lds;
    constexpr int BUFSZ = 10752;
    LAS float* ybase = L + 2 * BUFSZ;
    constexpr int NCH = SEQ / 32;
    if (wave < 4) {
        const int jg = lane & 15, rA = wave * 4 + (lane >> 4);
        f32x2 SaA = (f32x2){0.f, 0.f}, SbA = (f32x2){0.f, 0.f};
        __syncthreads();
        for (int cc = 0; cc < NCH; ++cc) {
            const LAS float* buf = L + (cc & 1) * BUFSZ; LAS float* ybuf = ybase + (cc & 1) * 512;
            const LAS float* bj = buf + 4 * jg; const LAS float* bv = buf + 10240 + rA;
            f32x4 w4 = *(const LAS f32x4*)(bj), k4 = *(const LAS f32x4*)(bj + 2048), a4 = *(const LAS f32x4*)(bj + 4096), b4 = *(const LAS f32x4*)(bj + 6144), r4 = *(const LAS f32x4*)(bj + 8192);
            float vi = bv[0], ykA = 0.f;
#pragma unroll
            for (int st = 0; st < 32; ++st) {
                const f32x4 nw4 = *(const LAS f32x4*)(bj + (st + 1) * 64), nk4 = *(const LAS f32x4*)(bj + 2048 + (st + 1) * 64), na4 = *(const LAS f32x4*)(bj + 4096 + (st + 1) * 64),
                            nb4 = *(const LAS f32x4*)(bj + 6144 + (st + 1) * 64), nr4 = *(const LAS f32x4*)(bj + 8192 + (st + 1) * 64);
                const float nvi = bv[(st + 1) * 16];
                const f32x2 a01 = (f32x2){a4[0], a4[1]}, a23 = (f32x2){a4[2], a4[3]}, w01 = (f32x2){w4[0], w4[1]}, w23 = (f32x2){w4[2], w4[3]}, k01 = (f32x2){k4[0], k4[1]}, k23 = (f32x2){k4[2], k4[3]};
                const f32x2 b01 = (f32x2){b4[0], b4[1]}, b23 = (f32x2){b4[2], b4[3]}, r01 = (f32x2){r4[0], r4[1]}, r23 = (f32x2){r4[2], r4[3]};
                const f32x2 dA = SaA * a01 + SbA * a23;
                const f32x2 taA = SaA * w01 + vi * k01, tbA = SbA * w23 + vi * k23;
                const float saA = dsum16(dA.x + dA.y);
                SaA = saA * b01 + taA; SbA = saA * b23 + tbA;
                const f32x2 yA2 = SaA * r01 + SbA * r23;
                const float yA = dsum16(yA2.x + yA2.y);
                ykA = ((st & 15) == jg) ? yA : ykA;
                if ((st & 15) == 15) ybuf[(st - 15 + jg) * 16 + rA] = ykA;
                w4 = nw4; k4 = nk4; a4 = na4; b4 = nb4; r4 = nr4; vi = nvi;
            }
            __syncthreads();
        }
        __syncthreads();
    } else {
        const int ft = tid - 256;
        f32x4 sd[2]; u32x4 sk, sa, sb, sr, sv;
#define RW_LOAD(cc_) do { const size_t tb_ = tokb + (size_t)(cc_) * 32; \
            _Pragma("unroll") for (int q = 0; q < 2; ++q) { const int pc = ft + 256 * q; sd[q] = *(const f32x4*)(c.DEC() + (tb_ + (pc >> 4)) * 256 + cb + (pc & 15) * 4); } \
            { const size_t o_ = (tb_ + (ft >> 3)) * 256 + cb + (ft & 7) * 8; sk = *(const u32x4*)(c.KM() + o_); sa = *(const u32x4*)(c.AN() + o_); sb = *(const u32x4*)(c.BN() + o_); sr = *(const u32x4*)(c.R() + o_); } \
            if (ft < 64) sv = *(const u32x4*)(c.V() + (tb_ + (ft >> 1)) * 256 + cb + rb + (ft & 1) * 8); } while (0)
#define RW_PUT8(dst, v_) do { *(LAS f32x4*)(dst) = (f32x4){bflo((v_).x), bfhi((v_).x), bflo((v_).y), bfhi((v_).y)}; *(LAS f32x4*)((dst) + 4) = (f32x4){bflo((v_).z), bfhi((v_).z), bflo((v_).w), bfhi((v_).w)}; } while (0)
#define RW_STAGE(cc_) do { LAS float* B_ = L + ((cc_) & 1) * BUFSZ; \
            _Pragma("unroll") for (int q = 0; q < 2; ++q) { const int pc = ft + 256 * q; *(LAS f32x4*)(B_ + (pc >> 4) * 64 + (pc & 15) * 4) = sd[q]; } \
            { LAS float* d_ = B_ + (ft >> 3) * 64 + (ft & 7) * 8; RW_PUT8(d_ + 2048, sk); RW_PUT8(d_ + 4096, sa); RW_PUT8(d_ + 6144, sb); RW_PUT8(d_ + 8192, sr); } \
            if (ft < 64) { LAS float* d_ = B_ + 10240 + (ft >> 1) * 16 + (ft & 1) * 8; RW_PUT8(d_, sv); } } while (0)
#define RW_YOUT(cc_) do { if (ft < 128) { const f32x4 y_ = *(const LAS f32x4*)(ybase + ((cc_) & 1) * 512 + (ft >> 2) * 16 + (ft & 3) * 4); \
            *(f32x4*)(c.YRAW() + (tokb + (size_t)(cc_) * 32 + (ft >> 2)) * 256 + cb + rb + (ft & 3) * 4) = y_; } } while (0)
        RW_LOAD(0); RW_STAGE(0); RW_LOAD(1);
        __syncthreads();
        for (int cc = 0; cc < NCH; ++cc) {
            if (cc + 1 < NCH) RW_STAGE(cc + 1);
            if (cc + 2 < NCH) RW_LOAD(cc + 2);
            if (cc > 0) RW_YOUT(cc - 1);
            __syncthreads();
        }
        RW_YOUT(NCH - 1);
        __syncthreads();
#undef RW_LOAD
#undef RW_PUT8
#undef RW_STAGE
#undef RW_YOUT
    }
}

__device__ __forceinline__ void gla_item(const Ctx& c, int l, int item) {
    const int tid = otid(), lane = tid & 63, wave = __builtin_amdgcn_readfirstlane(tid >> 6);
    const int h = item & 3, b = item >> 2; const size_t tokb = (size_t)b * SEQ;
    LAS float* L = (LAS float*)c.lds;
    LAS float* obase = L + 2 * 10240;
    const bf16_t* P = c.P();
    bf16_t* Yg = c.Y() + (size_t)2 * NTOK * 256;
    constexpr int NCH = SEQ / 64;
    if (wave < 4) {
        const int vl = lane >> 3, dq = lane & 7;
        f32x2 Sa0 = (f32x2){0.f, 0.f}, Sb0 = (f32x2){0.f, 0.f}, Sa1 = (f32x2){0.f, 0.f}, Sb1 = (f32x2){0.f, 0.f};
        __syncthreads();
        for (int cc = 0; cc < NCH; ++cc) {
            const LAS float* B = L + (cc & 1) * 10240; LAS float* ob = obase + (cc & 1) * 4096;
            const LAS float* pq = B + 4 * dq; const LAS float* pk = B + 2048 + 4 * dq; const LAS float* pa = B + 4096 + 4 * dq; const LAS float* pv = B + 6144 + wave * 16 + 2 * vl;
            f32x4 a4 = *(const LAS f32x4*)pa, k4 = *(const LAS f32x4*)pk, q4 = *(const LAS f32x4*)pq; f32x2 vv = *(const LAS f32x2*)pv; float ok0 = 0.f, ok1 = 0.f;
#pragma unroll 16
            for (int st = 0; st < 64; ++st) {
                const int sn = (st + 1) & 63;
                const f32x4 na4 = *(const LAS f32x4*)(pa + sn * 32), nk4 = *(const LAS f32x4*)(pk + sn * 32), nq4 = *(const LAS f32x4*)(pq + sn * 32); const f32x2 nvv = *(const LAS f32x2*)(pv + sn * 64);
                const f32x2 a01 = (f32x2){a4[0], a4[1]}, a23 = (f32x2){a4[2], a4[3]}, k01 = (f32x2){k4[0], k4[1]}, k23 = (f32x2){k4[2], k4[3]}, q01 = (f32x2){q4[0], q4[1]}, q23 = (f32x2){q4[2], q4[3]};
                Sa0 = Sa0 * a01 + vv.x * k01; Sb0 = Sb0 * a23 + vv.x * k23;
                Sa1 = Sa1 * a01 + vv.y * k01; Sb1 = Sb1 * a23 + vv.y * k23;
                const f32x2 o0 = Sa0 * q01 + Sb0 * q23, o1 = Sa1 * q01 + Sb1 * q23;
                const float r0 = dsum8(o0.x + o0.y), r1 = dsum8(o1.x + o1.y);
                ok0 = ((st & 7) == dq) ? r0 : ok0; ok1 = ((st & 7) == dq) ? r1 : ok1;
                if ((st & 7) == 7) *(LAS f32x2*)(ob + (st - 7 + dq) * 64 + wave * 16 + 2 * vl) = (f32x2){ok0, ok1};
                a4 = na4; k4 = nk4; q4 = nq4; vv = nvv;
            }
            __syncthreads();
        }
        __syncthreads();
    } else {
        const int ft = tid - 256;
        const float* a2 = c.in(20) + (size_t)l * 16 * 128; const float* ab = c.in(21) + l * 128;
        float a2c[16];
#pragma unroll
        for (int j = 0; j < 16; ++j) a2c[j] = a2[j * 128 + h * 32 + (ft & 31)];
        const float abv = ab[h * 32 + (ft & 31)];
        const int nvq = ft & 3;
        f32x4 lg[4];
#pragma unroll
        for (int i = 0; i < 4; ++i) lg[i] = *(const f32x4*)(c.in(22) + l * 256 + h * 64 + nvq * 16 + 4 * i);
        u32x4 rq, rk, rv[2];
#define GLA_LOAD(cc_) do { const size_t tb_ = tokb + (size_t)(cc_) * 64; \
            rq = *(const u32x4*)(P + (tb_ + (ft >> 2)) * PLD + C_GQ + h * 32 + (ft & 3) * 8); rk = *(const u32x4*)(P + (tb_ + (ft >> 2)) * PLD + C_GK + h * 32 + (ft & 3) * 8); \
            _Pragma("unroll") for (int q = 0; q < 2; ++q) { const int pc = ft + 256 * q; rv[q] = *(const u32x4*)(P + (tb_ + (pc >> 3)) * PLD + C_GV + h * 64 + (pc & 7) * 8); } } while (0)
#define GLA_STAGE(cc_) do { LAS float* B_ = L + ((cc_) & 1) * 10240; const size_t tb_ = tokb + (size_t)(cc_) * 64; const float qsc = 0.17677669529663687f; \
            { LAS float* d_ = B_ + (ft >> 2) * 32 + (ft & 3) * 8; \
              *(LAS f32x4*)d_ = (f32x4){bflo(rq.x) * qsc, bfhi(rq.x) * qsc, bflo(rq.y) * qsc, bfhi(rq.y) * qsc}; *(LAS f32x4*)(d_ + 4) = (f32x4){bflo(rq.z) * qsc, bfhi(rq.z) * qsc, bflo(rq.w) * qsc, bfhi(rq.w) * qsc}; \
              *(LAS f32x4*)(d_ + 2048) = (f32x4){bflo(rk.x), bfhi(rk.x), bflo(rk.y), bfhi(rk.y)}; *(LAS f32x4*)(d_ + 2052) = (f32x4){bflo(rk.z), bfhi(rk.z), bflo(rk.w), bfhi(rk.w)}; } \
            _Pragma("unroll") for (int q = 0; q < 2; ++q) { const int pc = ft + 256 * q; LAS float* d_ = B_ + 6144 + (pc >> 3) * 64 + (pc & 7) * 8; \
              *(LAS f32x4*)d_ = (f32x4){bflo(rv[q].x), bfhi(rv[q].x), bflo(rv[q].y), bfhi(rv[q].y)}; *(LAS f32x4*)(d_ + 4) = (f32x4){bflo(rv[q].z), bfhi(rv[q].z), bflo(rv[q].w), bfhi(rv[q].w)}; } \
              \
            _Pragma("unroll") for (int i = 0; i < 8; ++i) { const int t_ = (ft >> 5) * 8 + i; const bf16_t* gp = P + (tb_ + t_) * PLD + C_GZ; \
              const u32x4 z0 = *(const u32x4*)gp, z1 = *(const u32x4*)(gp + 8); \
              float z = abv; \
              z += bflo(z0.x) * a2c[0] + bfhi(z0.x) * a2c[1] + bflo(z0.y) * a2c[2] + bfhi(z0.y) * a2c[3] + bflo(z0.z) * a2c[4] + bfhi(z0.z) * a2c[5] + bflo(z0.w) * a2c[6] + bfhi(z0.w) * a2c[7]; \
              z += bflo(z1.x) * a2c[8] + bfhi(z1.x) * a2c[9] + bflo(z1.y) * a2c[10] + bfhi(z1.y) * a2c[11] + bflo(z1.z) * a2c[12] + bfhi(z1.z) * a2c[13] + bflo(z1.w) * a2c[14] + bfhi(z1.w) * a2c[15]; \
              B_[4096 + t_ * 32 + (ft & 31)] = __expf(logsigf_(z) * (1.f / 16.f)); } } while (0)
#define GLA_NORM(cc_) do { const LAS float* ob_ = obase + ((cc_) & 1) * 4096 + (ft >> 2) * 64 + nvq * 16; const size_t tok_ = tokb + (size_t)(cc_) * 64 + (ft >> 2); \
            const bf16_t* gp_ = P + tok_ * PLD + C_GR + h * 64 + nvq * 16; const u32x4 g0 = *(const u32x4*)gp_, g1 = *(const u32x4*)(gp_ + 8); \
            f32x4 o_[4]; float ss = 0.f; \
            _Pragma("unroll") for (int i = 0; i < 4; ++i) { o_[i] = *(const LAS f32x4*)(ob_ + 4 * i); ss += (o_[i][0] * o_[i][0] + o_[i][1] * o_[i][1]) + (o_[i][2] * o_[i][2] + o_[i][3] * o_[i][3]); } \
            ss += dpp_mov<0xB1>(ss); ss += dpp_mov<0x4E>(ss); \
            const float rs = rsqrtf(ss * (1.f / 64.f) + 1e-5f); \
            u32x4 w0, w1; \
            w0.x = pack2(o_[0][0] * rs * lg[0][0] * siluf_(bflo(g0.x)), o_[0][1] * rs * lg[0][1] * siluf_(bfhi(g0.x))); w0.y = pack2(o_[0][2] * rs * lg[0][2] * siluf_(bflo(g0.y)), o_[0][3] * rs * lg[0][3] * siluf_(bfhi(g0.y))); \
            w0.z = pack2(o_[1][0] * rs * lg[1][0] * siluf_(bflo(g0.z)), o_[1][1] * rs * lg[1][1] * siluf_(bfhi(g0.z))); w0.w = pack2(o_[1][2] * rs * lg[1][2] * siluf_(bflo(g0.w)), o_[1][3] * rs * lg[1][3] * siluf_(bfhi(g0.w))); \
            w1.x = pack2(o_[2][0] * rs * lg[2][0] * siluf_(bflo(g1.x)), o_[2][1] * rs * lg[2][1] * siluf_(bfhi(g1.x))); w1.y = pack2(o_[2][2] * rs * lg[2][2] * siluf_(bflo(g1.y)), o_[2][3] * rs * lg[2][3] * siluf_(bfhi(g1.y))); \
            w1.z = pack2(o_[3][0] * rs * lg[3][0] * siluf_(bflo(g1.z)), o_[3][1] * rs * lg[3][1] * siluf_(bfhi(g1.z))); w1.w = pack2(o_[3][2] * rs * lg[3][2] * siluf_(bflo(g1.w)), o_[3][3] * rs * lg[3][3] * siluf_(bfhi(g1.w))); \
            bf16_t* yp_ = Yg + tok_ * 256 + h * 64 + nvq * 16; *(u32x4*)yp_ = w0; *(u32x4*)(yp_ + 8) = w1; } while (0)
        GLA_LOAD(0); GLA_STAGE(0); GLA_LOAD(1);
        __syncthreads();
        for (int cc = 0; cc < NCH; ++cc) {
            if (cc + 1 < NCH) GLA_STAGE(cc + 1);
            if (cc + 2 < NCH) GLA_LOAD(cc + 2);
            if (cc > 0) GLA_NORM(cc - 1);
            __syncthreads();
        }
        GLA_NORM(NCH - 1);
        __syncthreads();
#undef GLA_LOAD
#undef GLA_STAGE
#undef GLA_NORM
    }
}

template <int D, bool FOX>
__device__ __forceinline__ void attn_block(LAS unsigned char* lds, const bf16_t* Q, int ldq, const bf16_t* Kp, int ldk, const bf16_t* Vp, int ldv,
                                           bf16_t* O, int ldo, int q0, int nkeys, float scale, const float* cvec) {
    constexpr int KLD = D + 8, VLD = 72, NKS = D / 32, NDT = D / 16;
    const int tid = otid(), lane = tid & 63, wave = tid >> 6, r = lane & 15, g = lane >> 4;
    LAS bf16_t* Ks = (LAS bf16_t*)lds;
    LAS bf16_t* Vt = Ks + 64 * KLD;
    LAS float* ckb = (LAS float*)(Vt + D * VLD);
    const int qrow = q0 + 16 * wave + r;
    bf16x8 Qf[NKS];
#pragma unroll
    for (int ks = 0; ks < NKS; ++ks) Qf[ks] = *(const bf16x8*)(Q + (size_t)qrow * ldq + ks * 32 + 8 * g);
    float cq = 0.f; if (FOX) cq = cvec[(size_t)qrow * 4];
    f32x4 Oacc[NDT];
#pragma unroll
    for (int dt = 0; dt < NDT; ++dt) Oacc[dt] = (f32x4){0.f, 0.f, 0.f, 0.f};
    float mrun = -1e30f, lsum = 0.f;
    const int nch = nkeys / 64;
    constexpr int NQ = (64 * D / 8) / 512;
    u32x4 kreg[NQ], vreg[NQ]; float ckr = 0.f;
#define ATT_LOAD(chn) do { const int k0_ = (chn) * 64; \
        _Pragma("unroll") for (int q = 0; q < NQ; ++q) { const int pidx = tid + 512 * q; const int key = pidx / (D / 8), dc = pidx % (D / 8); \
            kreg[q] = *(const u32x4*)(Kp + (size_t)(k0_ + key) * ldk + dc * 8); vreg[q] = *(const u32x4*)(Vp + (size_t)(k0_ + key) * ldv + dc * 8); } \
        if (FOX) { if (tid < 64) ckr = cvec[(size_t)(k0_ + tid) * 4]; } } while (0)
    ATT_LOAD(0);
    for (int ch = 0; ch < nch; ++ch) {
        const int key0 = ch * 64;
#pragma unroll
        for (int q = 0; q < NQ; ++q) { const int pidx = tid + 512 * q; const int key = pidx / (D / 8), dc = pidx % (D / 8);
            *(LAS u32x4*)(Ks + key * KLD + dc * 8) = kreg[q];
            const u32x4 vv = vreg[q];
            LAS bf16_t* vd = Vt + (dc * 8) * VLD + (key ^ ((dc & 15) << 2));
            vd[0 * VLD] = (bf16_t)(vv.x & 0xffff); vd[1 * VLD] = (bf16_t)(vv.x >> 16); vd[2 * VLD] = (bf16_t)(vv.y & 0xffff); vd[3 * VLD] = (bf16_t)(vv.y >> 16);
            vd[4 * VLD] = (bf16_t)(vv.z & 0xffff); vd[5 * VLD] = (bf16_t)(vv.z >> 16); vd[6 * VLD] = (bf16_t)(vv.w & 0xffff); vd[7 * VLD] = (bf16_t)(vv.w >> 16); }
        if (FOX) { if (tid < 64) ckb[tid] = ckr; }
        __syncthreads();
        if (ch + 1 < nch) ATT_LOAD(ch + 1);
        const bool active = !FOX || (key0 <= q0 + 16 * wave + 15);
        if (active) {
            f32x4 s[4];
#pragma unroll
            for (int kt = 0; kt < 4; ++kt) { f32x4 a = (f32x4){0.f, 0.f, 0.f, 0.f};
#pragma unroll
                for (int ks = 0; ks < NKS; ++ks) { const bf16x8 kf = *(const LAS bf16x8*)(Ks + (kt * 16 + r) * KLD + ks * 32 + 8 * g);
                    a = __builtin_amdgcn_mfma_f32_16x16x32_bf16(kf, Qf[ks], a, 0, 0, 0); }
                s[kt] = a; }
            float mx = -1e30f;
#pragma unroll
            for (int kt = 0; kt < 4; ++kt)
#pragma unroll
                for (int reg = 0; reg < 4; ++reg) { float v = s[kt][reg] * scale;
                    if (FOX) { const int kl = kt * 16 + 4 * g + reg; v += cq - ckb[kl]; if (key0 + kl > qrow) v = -1e30f; }
                    s[kt][reg] = v; mx = fmaxf(mx, v); }
            mx = fmaxf(mx, __shfl_xor(mx, 16)); mx = fmaxf(mx, __shfl_xor(mx, 32));
            const float mnew = fmaxf(mrun, mx); const float corr = __expf(mrun - mnew); mrun = mnew;
            float ps = 0.f;
#pragma unroll
            for (int kt = 0; kt < 4; ++kt)
#pragma unroll
                for (int reg = 0; reg < 4; ++reg) { const float pv = __expf(s[kt][reg] - mnew); s[kt][reg] = pv; ps += pv; }
            lsum = lsum * corr + ps;
            bf16x8 pf[2];
#pragma unroll
            for (int s2 = 0; s2 < 2; ++s2) {
                u32x4 w; w.x = pack2(s[2 * s2][0], s[2 * s2][1]); w.y = pack2(s[2 * s2][2], s[2 * s2][3]); w.z = pack2(s[2 * s2 + 1][0], s[2 * s2 + 1][1]); w.w = pack2(s[2 * s2 + 1][2], s[2 * s2 + 1][3]);
                pf[s2] = __builtin_bit_cast(bf16x8, w); }
#pragma unroll
            for (int dt = 0; dt < NDT; ++dt) { f32x4 o = Oacc[dt] * corr;
#pragma unroll
                for (int s2 = 0; s2 < 2; ++s2) { const int sw = ((dt * 2 + (r >> 3)) & 15) << 2; const LAS bf16_t* vrow = Vt + (dt * 16 + r) * VLD;
                    const u32x2 lo = *(const LAS u32x2*)(vrow + ((s2 * 32 + 4 * g) ^ sw)), hi = *(const LAS u32x2*)(vrow + ((s2 * 32 + 16 + 4 * g) ^ sw));
                    u32x4 w; w.x = lo.x; w.y = lo.y; w.z = hi.x; w.w = hi.y;
                    o = __builtin_amdgcn_mfma_f32_16x16x32_bf16(__builtin_bit_cast(bf16x8, w), pf[s2], o, 0, 0, 0); }
                Oacc[dt] = o; }
        }
        __syncthreads();
    }
#undef ATT_LOAD
    lsum += __shfl_xor(lsum, 16); lsum += __shfl_xor(lsum, 32);
    const float inv = 1.f / lsum;
#pragma unroll
    for (int dt = 0; dt < NDT; ++dt) { u32x2 w; w.x = pack2(Oacc[dt][0] * inv, Oacc[dt][1] * inv); w.y = pack2(Oacc[dt][2] * inv, Oacc[dt][3] * inv);
        *(u32x2*)(O + (size_t)qrow * ldo + dt * 16 + 4 * g) = w; }
}

__device__ __forceinline__ void xattn_block(LAS unsigned char* lds, const bf16_t* Q, const bf16_t* Kp, const bf16_t* Vp, bf16_t* O, int q0) {
    constexpr int D = 256, KLD = D + 8, VLD = 72, ldq = 1024, ldk = 8192, ldo = 1024;
    const int tid = otid(), lane = tid & 63, wave = tid >> 6, r = lane & 15, g = lane >> 4;
    LAS bf16_t* Ks = (LAS bf16_t*)lds;
    LAS bf16_t* Vt = Ks + 64 * KLD;
    const int qrow = q0 + 16 * wave + r;
    u32x4 stg[4];
#define XA_LOAD(src, chn) do { _Pragma("unroll") for (int q = 0; q < 4; ++q) { const int pidx = tid + 512 * q; const int key = pidx >> 5, dc = pidx & 31; \
        stg[q] = *(const u32x4*)((src) + (size_t)((chn) * 64 + key) * ldk + dc * 8); } } while (0)
    XA_LOAD(Kp, 0);
    bf16x8 pf[8];
    {
        bf16x8 Qf[8];
#pragma unroll
        for (int ks = 0; ks < 8; ++ks) Qf[ks] = *(const bf16x8*)(Q + (size_t)qrow * ldq + ks * 32 + 8 * g);
        f32x4 s[16];
#pragma unroll
        for (int ch = 0; ch < 4; ++ch) {
#pragma unroll
            for (int q = 0; q < 4; ++q) { const int pidx = tid + 512 * q; const int key = pidx >> 5, dc = pidx & 31; *(LAS u32x4*)(Ks + key * KLD + dc * 8) = stg[q]; }
            __syncthreads();
            if (ch < 3) XA_LOAD(Kp, ch + 1); else XA_LOAD(Vp, 0);
#pragma unroll
            for (int kt = 0; kt < 4; ++kt) { f32x4 a = (f32x4){0.f, 0.f, 0.f, 0.f};
#pragma unroll
                for (int ks = 0; ks < 8; ++ks) { const bf16x8 kf = *(const LAS bf16x8*)(Ks + (kt * 16 + r) * KLD + ks * 32 + 8 * g);
                    a = __builtin_amdgcn_mfma_f32_16x16x32_bf16(kf, Qf[ks], a, 0, 0, 0); }
                s[ch * 4 + kt] = a; }
            __syncthreads();
        }
        float mx = -1e30f;
#pragma unroll
        for (int i = 0; i < 16; ++i) { s[i] = s[i] * 0.0625f; mx = fmaxf(mx, fmaxf(fmaxf(s[i][0], s[i][1]), fmaxf(s[i][2], s[i][3]))); }
        mx = fmaxf(mx, __shfl_xor(mx, 16)); mx = fmaxf(mx, __shfl_xor(mx, 32));
        float ps = 0.f;
#pragma unroll
        for (int i = 0; i < 16; ++i) {
#pragma unroll
            for (int j = 0; j < 4; ++j) { const float pv = __expf(s[i][j] - mx); s[i][j] = pv; ps += pv; } }
        ps += __shfl_xor(ps, 16); ps += __shfl_xor(ps, 32);
        const float inv = 1.f / ps;
#pragma unroll
        for (int k2 = 0; k2 < 8; ++k2) {
            u32x4 w; w.x = pack2(s[2 * k2][0] * inv, s[2 * k2][1] * inv); w.y = pack2(s[2 * k2][2] * inv, s[2 * k2][3] * inv);
            w.z = pack2(s[2 * k2 + 1][0] * inv, s[2 * k2 + 1][1] * inv); w.w = pack2(s[2 * k2 + 1][2] * inv, s[2 * k2 + 1][3] * inv);
            pf[k2] = __builtin_bit_cast(bf16x8, w); }
    }
    f32x4 Oacc[16];
#pragma unroll
    for (int dt = 0; dt < 16; ++dt) Oacc[dt] = (f32x4){0.f, 0.f, 0.f, 0.f};
#pragma unroll
    for (int ch = 0; ch < 4; ++ch) {
#pragma unroll
        for (int q = 0; q < 4; ++q) { const int pidx = tid + 512 * q; const int key = pidx >> 5, dc = pidx & 31; const u32x4 vv = stg[q];
            LAS bf16_t* vd = Vt + (dc * 8) * VLD + (key ^ ((dc & 15) << 2));
            vd[0 * VLD] = (bf16_t)(vv.x & 0xffff); vd[1 * VLD] = (bf16_t)(vv.x >> 16); vd[2 * VLD] = (bf16_t)(vv.y & 0xffff); vd[3 * VLD] = (bf16_t)(vv.y >> 16);
            vd[4 * VLD] = (bf16_t)(vv.z & 0xffff); vd[5 * VLD] = (bf16_t)(vv.z >> 16); vd[6 * VLD] = (bf16_t)(vv.w & 0xffff); vd[7 * VLD] = (bf16_t)(vv.w >> 16); }
        __syncthreads();
        if (ch < 3) XA_LOAD(Vp, ch + 1);
#pragma unroll
        for (int dt = 0; dt < 16; ++dt) { f32x4 o = Oacc[dt];
#pragma unroll
            for (int s2 = 0; s2 < 2; ++s2) { const int sw = ((dt * 2 + (r >> 3)) & 15) << 2; const LAS bf16_t* vrow = Vt + (dt * 16 + r) * VLD;
                const u32x2 lo = *(const LAS u32x2*)(vrow + ((s2 * 32 + 4 * g) ^ sw)), hi = *(const LAS u32x2*)(vrow + ((s2 * 32 + 16 + 4 * g) ^ sw));
                u32x4 w; w.x = lo.x; w.y = lo.y; w.z = hi.x; w.w = hi.y;
                o = __builtin_amdgcn_mfma_f32_16x16x32_bf16(__builtin_bit_cast(bf16x8, w), pf[ch * 2 + s2], o, 0, 0, 0); }
            Oacc[dt] = o; }
        __syncthreads();
    }
#undef XA_LOAD
#pragma unroll
    for (int dt = 0; dt < 16; ++dt) { u32x2 w; w.x = pack2(Oacc[dt][0], Oacc[dt][1]); w.y = pack2(Oacc[dt][2], Oacc[dt][3]);
        *(u32x2*)(O + (size_t)qrow * ldo + dt * 16 + 4 * g) = w; }
}

__device__ __forceinline__ void fox_item(const Ctx& c, int s) {
    const int qt = 15 - (s >> 5), bh = s & 31, b = bh >> 2, h = bh & 3;
    const bf16_t* base = c.P() + (size_t)b * SEQ * PLD;
    attn_block<64, true>(c.lds, base + C_FQ + h * 64, PLD, base + C_FK + h * 64, PLD, base + C_FV + h * 64, PLD,
                         c.Y() + (size_t)3 * NTOK * 256 + (size_t)b * SEQ * 256 + h * 64, 256, qt * 128, qt * 128 + 128, 0.125f, c.CF() + (size_t)b * SEQ * 4 + h);
}

__device__ __forceinline__ void rw_post(const Ctx& c, int l) {
    const int tid = otid(), lane = tid & 63, wave = tid >> 6;
    const f32x4 lg = *(const f32x4*)(c.in(12) + l * 256 + 4 * lane), lb = *(const f32x4*)(c.in(13) + l * 256 + 4 * lane);
#pragma unroll 4
    for (int tok = c.bid * 8 + wave; tok < NTOK; tok += c.G * 8) {
        const f32x4 y = *(const f32x4*)(c.YRAW() + (size_t)tok * 256 + 4 * lane);
        const float mean = rsum16((y[0] + y[1]) + (y[2] + y[3])) * (1.f / 64.f);
        const f32x4 d = y - mean;
        const float var = rsum16((d[0] * d[0] + d[1] * d[1]) + (d[2] * d[2] + d[3] * d[3])) * (1.f / 64.f);
        const float rstd = rsqrtf(var + 64e-5f);
        f32x4 yn = d * rstd * lg + lb;
        const float bon = c.BON()[(size_t)tok * 4 + (lane >> 4)];
        const u32x2 vv = *(const u32x2*)(c.V() + (size_t)tok * 256 + 4 * lane), gg = *(const u32x2*)(c.Gg() + (size_t)tok * 256 + 4 * lane);
        yn[0] = (yn[0] + bon * bflo(vv.x)) * bflo(gg.x); yn[1] = (yn[1] + bon * bfhi(vv.x)) * bfhi(gg.x);
        yn[2] = (yn[2] + bon * bflo(vv.y)) * bflo(gg.y); yn[3] = (yn[3] + bon * bfhi(vv.y)) * bfhi(gg.y);
        u32x2 w; w.x = pack2(yn[0], yn[1]); w.y = pack2(yn[2], yn[3]);
        *(u32x2*)(c.Y() + (size_t)tok * 256 + 4 * lane) = w;
    }
}

__device__ __forceinline__ void ln_phase(const Ctx& c, int l, int which) {
    const int tid = otid(), lane = tid & 63, wave = tid >> 6;
    const float* gp = c.in(35) + (size_t)(l * 3 + which) * DM; const float* bp = c.in(36) + (size_t)(l * 3 + which) * DM;
    f32x4 gv[4], bv[4];
#pragma unroll
    for (int i = 0; i < 4; ++i) { gv[i] = *(const f32x4*)(gp + i * 256 + 4 * lane); bv[i] = *(const f32x4*)(bp + i * 256 + 4 * lane); }
#pragma unroll 2
    for (int row = c.bid * 8 + wave; row < NTOK; row += c.G * 8) {
        float* xr = c.X + (size_t)row * DM; f32x4 v[4]; float s = 0.f;
#pragma unroll
        for (int i = 0; i < 4; ++i) { v[i] = *(const f32x4*)(xr + i * 256 + 4 * lane); s += (v[i][0] + v[i][1]) + (v[i][2] + v[i][3]); }
        const float mean = wsum64(s) * (1.f / 1024.f); float q = 0.f;
#pragma unroll
        for (int i = 0; i < 4; ++i) { v[i] = v[i] - mean; q += (v[i][0] * v[i][0] + v[i][1] * v[i][1]) + (v[i][2] * v[i][2] + v[i][3] * v[i][3]); }
        const float rstd = rsqrtf(wsum64(q) * (1.f / 1024.f) + LN_EPS);
#pragma unroll
        for (int i = 0; i < 4; ++i) { const f32x4 y = v[i] * rstd * gv[i] + bv[i]; *(f32x4*)(xr + i * 256 + 4 * lane) = y;
            u32x2 w; w.x = pack2(y[0], y[1]); w.y = pack2(y[2], y[3]); *(u32x2*)(c.XB() + (size_t)row * DM + i * 256 + 4 * lane) = w; }
    }
}

#ifndef DUP_GEMM
#define DUP_GEMM 1
#endif
#ifndef DUP_MISC
#define DUP_MISC 1
#endif
__global__ void __launch_bounds__(512, 2) fwd_megakernel(Params p) {
    extern __shared__ __attribute__((aligned(16))) unsigned char lds_raw[];
    cg::grid_group grid = cg::this_grid();
    Ctx c; c.kin = (kin_t)__builtin_amdgcn_kernarg_segment_ptr(); c.ws = p.ws; c.X = p.out; c.lds = (LAS unsigned char*)lds_raw; c.G = gridDim.x; c.bid = blockIdx.x;
    const int G = c.G, bid = c.bid;

#ifndef PH
#define PH 0x3FFFF
#endif
    unsigned* barw = (unsigned*)(p.ws + WS_BAR);
    volatile LAS unsigned* stw = (volatile LAS unsigned*)(c.lds + 131072);
    if (threadIdx.x < 4) stw[threadIdx.x] = 0u;
    if (bid == 0) for (int i = threadIdx.x; i < XCD_BAR_WORDS; i += 512) barw[i] = 0u;
    prepass(c);
    grid.sync();
    const XcdBarrier xbar = xcd_barrier_post(barw, stw);
#define GSYNC() xcd_barrier(xbar)
    {
        pg8::Gemm g{c.Memb(), c.WkvT(), 1024, 1024, 1024}; pg8::StaticOrder S; S.init(2048, 8192, G, bid);
        pg8::EpiStoreBf16 E{c.KV(), 8192};
        if (PH & 0x10000) pg8::gemm_phase(c.lds, g, S, E);
    }
    for (int l = 0; l < DEPTH; ++l) {
        {
            pg8::Gemm g{c.XB(), c.WinT(), 1024, 1024, 1024}; pg8::StaticOrder S; S.init(NTOK, PLD, G, bid);
            pg8::EpiStoreBf16 E{c.P(), PLD};
            for (int d_ = 0; d_ < DUP_GEMM; ++d_) pg8::gemm_phase(c.lds, g, S, E);
        }
        GSYNC();
        for (int d_ = 0; d_ < DUP_MISC; ++d_) {
        if (PH & 4) for (int t = bid; t < 256; t += G) rw_prep_tile(c, l, t);
        if (PH & 8) for (int t = bid; t < 512; t += G) conv_tile(c, l, t);
        if (PH & 16) for (int t = bid; t < NB; t += G) fox_cumsum(c, l, t);
        }
        GSYNC();
#ifndef DUP_P2B
#define DUP_P2B 1
#endif
        for (int rep = 0; rep < DUP_P2B; ++rep) {
#ifndef DUP_SCAN
#define DUP_SCAN 1
#endif
#ifndef DUP_GLA
#define DUP_GLA 1
#endif
#ifndef DUP_FOX
#define DUP_FOX 1
#endif
        if (bid < 128) { for (int d_ = 0; d_ < DUP_SCAN; ++d_) rw_scan_item(c, bid); }
        else if (bid < 160) { for (int d_ = 0; d_ < DUP_GLA; ++d_) gla_item(c, l, bid - 128); }
        else for (int d_ = 0; d_ < DUP_FOX; ++d_) { const int j = bid - 160, nbf = G - 160;
            for (int rnd = 0; rnd * nbf < 512; ++rnd) { const int pos = rnd * nbf + ((rnd & 1) ? (nbf - 1 - j) : j); if (pos < 512) fox_item(c, pos); } }
        GSYNC();
        }
        for (int d_ = 0; d_ < DUP_MISC; ++d_) rw_post(c, l);
        GSYNC();
        {
            pg8::Gemm g{c.Y(), c.UpT(), 256, 256, 256}; pg8::MergeOrder S; S.so.init(NTOK, 1024, G, bid);
            pg8::EpiMerge E{c.P(), c.in(26) + (size_t)l * 4 * 1024, c.XB()};
            for (int d_ = 0; d_ < DUP_MISC; ++d_) pg8::gemm_phase(c.lds, g, S, E);
        }
        GSYNC();
        {
            pg8::Gemm g{c.XB(), c.WoutT(), 1024, 1024, 1024}; pg8::StaticOrder S; S.init(NTOK, 1024, G, bid);
            pg8::EpiResid E{c.X};
            if (PH & 1024) pg8::gemm_phase(c.lds, g, S, E);
        }
        GSYNC();
        if (PH & 2048) ln_phase(c, l, 0);
        GSYNC();
        {
            pg8::Gemm g{c.XB(), c.WqT(), 1024, 1024, 1024}; pg8::StaticOrder S; S.init(NTOK, 1024, G, bid);
            pg8::EpiStoreBf16 E{c.Qb(), 1024};
            for (int d_ = 0; d_ < DUP_GEMM; ++d_) pg8::gemm_phase(c.lds, g, S, E);
        }
        GSYNC();
        for (int d_ = 0; d_ < DUP_MISC; ++d_) for (int it = bid; it < 512; it += G) { const int qt = it & 15, bh = it >> 4, b = bh >> 2, h = bh & 3;
            const bf16_t* kb = c.KV() + (size_t)b * 256 * 8192 + l * 2048 + h * 256;
            xattn_block(c.lds, c.Qb() + (size_t)b * SEQ * 1024 + h * 256, kb, kb + 1024, c.Ob() + (size_t)b * SEQ * 1024 + h * 256, qt * 128); }
        GSYNC();
        {
            pg8::Gemm g{c.Ob(), c.WoT(), 1024, 1024, 1024}; pg8::StaticOrder S; S.init(NTOK, 1024, G, bid);
            pg8::EpiResid E{c.X};
            if (PH & 1024) pg8::gemm_phase(c.lds, g, S, E);
        }
        GSYNC();
        if (PH & 2048) ln_phase(c, l, 1);
        GSYNC();
        {
            pg8::Gemm g{c.XB(), c.FfuT(), 1024, 1024, 1024}; pg8::StaticOrder S; S.init(NTOK, 2 * DFF, G, bid);
            pg8::EpiSwiglu E{c.Hb()};
            for (int d_ = 0; d_ < DUP_GEMM; ++d_) pg8::gemm_phase(c.lds, g, S, E);
        }
        GSYNC();
        {
            pg8::Gemm g{c.Hb(), c.FfdT(), DFF, DFF, DFF}; pg8::StaticOrder S; S.init(NTOK, 1024, G, bid);
            pg8::EpiResid E{c.X};
            if (PH & 1024) pg8::gemm_phase(c.lds, g, S, E);
        }
        GSYNC();
        if (PH & 2048) ln_phase(c, l, 2);
        if ((PH & 1) && l + 1 < DEPTH) { __syncthreads(); convert_layer(c, l + 1); }
        GSYNC();
    }
}

extern "C" void kernel_launch(void* const* d_in, const int* in_sizes, int n_in, void* d_out, int out_size, void* d_ws, size_t ws_size, hipStream_t stream) {
    static int grid_blocks = 0;
    if (grid_blocks == 0) {
        if (n_in != 37 || out_size != NTOK * DM || ws_size < WS_END) { fprintf(stderr, "kernel_launch: unexpected shapes (n_in %d out %d ws %zu need %zu)\n", n_in, out_size, ws_size, (size_t)WS_END); grid_blocks = -1; return; }
        if (hipFuncSetAttribute((const void*)fwd_megakernel, hipFuncAttributeMaxDynamicSharedMemorySize, LDS_BYTES) != hipSuccess) { fprintf(stderr, "kernel_launch: hipFuncSetAttribute failed\n"); grid_blocks = -1; return; }
        int dev = 0, cus = 0, per_cu = 0;
        (void)hipGetDevice(&dev); (void)hipDeviceGetAttribute(&cus, hipDeviceAttributeMultiprocessorCount, dev);
        (void)hipOccupancyMaxActiveBlocksPerMultiprocessor(&per_cu, (const void*)fwd_megakernel, 512, LDS_BYTES);
        if (per_cu < 1) { fprintf(stderr, "kernel_launch: occupancy query says %d blocks per CU\n", per_cu); per_cu = 1; }
        (void)hipGetLastError();
        grid_blocks = cus;
        if (grid_blocks < 192) { fprintf(stderr, "kernel_launch: too few CUs (%d)\n", cus); grid_blocks = -1; return; }
    }
    if (grid_blocks < 0) return;
    Params p{};
    for (int i = 0; i < 37; ++i) p.in[i] = (const float*)d_in[i];
    p.out = (float*)d_out; p.ws = (unsigned char*)d_ws;
    void* args[] = {&p};
    hipError_t e = hipLaunchCooperativeKernel((const void*)fwd_megakernel, dim3(grid_blocks), dim3(512), args, LDS_BYTES, stream);
    if (e != hipSuccess) fprintf(stderr, "cooperative launch failed: %s (grid %d)\n", hipGetErrorString(e), grid_blocks);
}
```

```cpp
#include <hip/hip_runtime.h>
#include <hip/hip_cooperative_groups.h>
#include <cstdio>
namespace cg = cooperative_groups;

#define LAS __attribute__((address_space(3)))
typedef unsigned short bf16_t;
typedef short bf16x8 __attribute__((ext_vector_type(8)));
typedef float f32x4 __attribute__((ext_vector_type(4)));
typedef unsigned u32x4 __attribute__((ext_vector_type(4)));
typedef unsigned u32x2 __attribute__((ext_vector_type(2)));

constexpr int NTOK = 16384, DM = 1024, SEQ = 2048, NB = 8, DEPTH = 4, DIN = 7220, PLD = 7424, DFF = 2816;
constexpr int C_RWR = 0, C_RWK = 256, C_RWV = 512, C_LORA = 768, C_CVA = 1056, C_CVB = 1312, C_GQ = 1568, C_GK = 1696, C_GV = 1824, C_GR = 2080,
              C_GZ = 2336, C_FQ = 2352, C_FK = 2608, C_FV = 2864, C_FZ = 3120, C_GATE = 3328;
constexpr float ALPHA = 1.681792830507429f;
constexpr float LN_EPS = 1e-5f;

constexpr size_t WS_WIN = 0;
constexpr size_t WS_UP = WS_WIN + (size_t)PLD * 1024 * 2;
constexpr size_t WS_WOUT = WS_UP + (size_t)4 * 1024 * 256 * 2;
constexpr size_t WS_WQ = WS_WOUT + (size_t)1024 * 1024 * 2;
constexpr size_t WS_WO = WS_WQ + (size_t)1024 * 1024 * 2;
constexpr size_t WS_FFU = WS_WO + (size_t)1024 * 1024 * 2;
constexpr size_t WS_FFD = WS_FFU + (size_t)5632 * 1024 * 2;
constexpr size_t WS_KV = WS_FFD + (size_t)1024 * DFF * 2;
constexpr size_t WS_XB = WS_KV + (size_t)2048 * 8192 * 2;
constexpr size_t WS_Y = WS_XB + (size_t)NTOK * 1024 * 2;
constexpr size_t WS_DEC = WS_Y + (size_t)4 * NTOK * 256 * 2;
constexpr size_t WS_R = WS_DEC + (size_t)NTOK * 256 * 4;
constexpr size_t WS_KM = WS_R + (size_t)NTOK * 256 * 2;
constexpr size_t WS_V = WS_KM + (size_t)NTOK * 256 * 2;
constexpr size_t WS_AN = WS_V + (size_t)NTOK * 256 * 2;
constexpr size_t WS_BN = WS_AN + (size_t)NTOK * 256 * 2;
constexpr size_t WS_CF = WS_BN + (size_t)NTOK * 256 * 2;
constexpr size_t WS_P = WS_CF + (size_t)NTOK * 4 * 4;
constexpr size_t WS_LORA = WS_P + (size_t)NTOK * PLD * 2;
constexpr size_t WS_BAR = WS_LORA + (size_t)256 * 288 * 2;
constexpr size_t WS_KMAX = WS_BAR + 16384;
constexpr size_t WS_END = WS_KMAX + 1024;
constexpr size_t XB_YRAW = 0, XB_G = (size_t)NTOK * 256 * 4, XB_BON = XB_G + (size_t)NTOK * 256 * 2;
constexpr size_t Y_MEMB = 0, Y_WKV = (size_t)2048 * 1024 * 2;
constexpr size_t P_Q = 0, P_O = (size_t)NTOK * 1024 * 2, P_H = (size_t)2 * NTOK * 1024 * 2;

constexpr int LDS_BYTES = 131072 + 16;

struct Params { const float* in[37]; float* out; unsigned char* ws; };

__device__ __forceinline__ float bf2f(bf16_t b) { return __uint_as_float(((unsigned)b) << 16); }
__device__ __forceinline__ float bflo(unsigned w) { return __uint_as_float(w << 16); }
__device__ __forceinline__ float bfhi(unsigned w) { return __uint_as_float(w & 0xffff0000u); }
__device__ __forceinline__ bf16_t f2bf(float f) { unsigned u = __float_as_uint(f); u += 0x7FFFu + ((u >> 16) & 1u); return (bf16_t)(u >> 16); }
__device__ __forceinline__ unsigned pack2(float lo, float hi) { return (unsigned)f2bf(lo) | ((unsigned)f2bf(hi) << 16); }
__device__ __forceinline__ float sigmoidf_(float x) { return 1.0f / (1.0f + __expf(-x)); }
__device__ __forceinline__ float siluf_(float x) { return x / (1.0f + __expf(-x)); }
__device__ __forceinline__ float logsigf_(float x) { return fminf(x, 0.f) - log1pf(__expf(-fabsf(x))); }
__device__ __forceinline__ float wsum64(float v) { v += __shfl_xor(v, 32); v += __shfl_xor(v, 16); v += __shfl_xor(v, 8); v += __shfl_xor(v, 4); v += __shfl_xor(v, 2); v += __shfl_xor(v, 1); return v; }
__device__ __forceinline__ float rsum16(float v) { v += __shfl_xor(v, 8); v += __shfl_xor(v, 4); v += __shfl_xor(v, 2); v += __shfl_xor(v, 1); return v; }

typedef float f32x2 __attribute__((ext_vector_type(2)));
template <int CTRL> __device__ __forceinline__ float dpp_mov(float x) { return __int_as_float(__builtin_amdgcn_update_dpp(0, __float_as_int(x), CTRL, 0xF, 0xF, true)); }
__device__ __forceinline__ float dsum16(float x) { x += dpp_mov<0xB1>(x); x += dpp_mov<0x4E>(x); x += dpp_mov<0x124>(x); x += dpp_mov<0x128>(x); return x; }
__device__ __forceinline__ float dsum8(float x) { x += dpp_mov<0xB1>(x); x += dpp_mov<0x4E>(x); x += dpp_mov<0x141>(x); return x; }
__device__ __forceinline__ int otid() { int t = threadIdx.x; asm volatile("" : "+v"(t)); return t; }


#define XB_TMO      128
#define XB_XCNT(j)  (256  + 64 * (j))
#define XB_XSUB(j)  (1280 + 64 * (j))
#define XB_XGEN(j)  (2304 + 64 * (j))
#define XB_TOP      3328
#define XB_TOPGEN   3392
#define XCD_BAR_WORDS 3456
#define XB_SPIN_CAP (1u << 18)
__device__ __forceinline__ unsigned xb_ld(unsigned* p)              { return __hip_atomic_load(p, __ATOMIC_RELAXED, __HIP_MEMORY_SCOPE_AGENT); }
__device__ __forceinline__ unsigned xb_add(unsigned* p, unsigned v) { return __hip_atomic_fetch_add(p, v, __ATOMIC_RELAXED, __HIP_MEMORY_SCOPE_AGENT); }
__device__ __forceinline__ unsigned xb_xcc_id() { return (unsigned)__builtin_amdgcn_s_getreg((3 << 11) | 20) & 0xFu; }
#define XB_SPIN(cond, bar) do { unsigned _sp = 0; while (cond) { __builtin_amdgcn_s_sleep(1); \
    if ((++_sp & 255u) == 0u) { if (xb_ld(&(bar)[XB_TMO])) break; if (_sp > XB_SPIN_CAP) { atomicAdd(&(bar)[XB_TMO], 1u); break; } } } } while (0)
struct XcdBarrier { unsigned* bar; unsigned x; volatile LAS unsigned* st; };
__device__ __forceinline__ XcdBarrier xcd_barrier_post(unsigned* bar, volatile LAS unsigned* st) {
    XcdBarrier b; b.bar = bar; b.x = xb_xcc_id(); b.st = st;
    if (threadIdx.x == 0) (void)xb_add(&bar[XB_XCNT(b.x)], 1u);
    return b;
}
__device__ __forceinline__ void xcd_barrier_complete(unsigned* bar, unsigned x, unsigned& nloc, unsigned& nx) {
    const unsigned G = gridDim.x * gridDim.y * gridDim.z;
    unsigned sum, cnt, mine, sp = 0u;
    for (;;) {
        sum = 0u; cnt = 0u; mine = 0u;
#pragma unroll
        for (unsigned j = 0; j < 16; ++j) { const unsigned c = xb_ld(&bar[XB_XCNT(j)]); sum += c; cnt += (c > 0u) ? 1u : 0u; mine = (j == x) ? c : mine; }
        if (sum == G) break;
        __builtin_amdgcn_s_sleep(1);
        if ((++sp & 255u) == 0u) { if (xb_ld(&bar[XB_TMO])) break; if (sp > XB_SPIN_CAP) { atomicAdd(&bar[XB_TMO], 1u); break; } }
    }
    nloc = mine > 0u ? mine : 1u; nx = cnt > 0u ? cnt : 1u;
}
__device__ __forceinline__ void xcd_barrier(const XcdBarrier& b) {
    asm volatile("s_waitcnt vmcnt(0)" ::: "memory");
    __syncthreads();
    if (threadIdx.x == 0) {
        unsigned* bar = b.bar;
        __builtin_amdgcn_s_waitcnt(0);
        unsigned nloc = b.st[0], nx = b.st[1];
        if (nloc == 0u) { xcd_barrier_complete(bar, b.x, nloc, nx); b.st[0] = nloc; b.st[1] = nx; }
        const unsigned old = xb_add(&bar[XB_XSUB(b.x)], 1u);
        const unsigned gen = old / nloc;
        if (old + 1u == (gen + 1u) * nloc) {
            __builtin_amdgcn_fence(__ATOMIC_RELEASE, "agent");
            asm volatile("s_waitcnt vmcnt(0)" ::: "memory");
            const unsigned og = xb_add(&bar[XB_TOP], 1u);
            const unsigned tg = og / nx;
            if (og + 1u == (tg + 1u) * nx) xb_add(&bar[XB_TOPGEN], 1u);
            else XB_SPIN(xb_ld(&bar[XB_TOPGEN]) == tg, bar);
            __builtin_amdgcn_fence(__ATOMIC_ACQUIRE, "agent");
            xb_add(&bar[XB_XGEN(b.x)], 1u);
            asm volatile("s_waitcnt vmcnt(0)" ::: "memory");
        } else {
            XB_SPIN(xb_ld(&bar[XB_XGEN(b.x)]) == gen, bar);
            __builtin_amdgcn_fence(__ATOMIC_ACQUIRE, "agent");
            asm volatile("s_waitcnt vmcnt(0)" ::: "memory");
        }
    }
    __syncthreads();
}

namespace pg8 {
constexpr int BM = 256, BK = 64, HALF = 128, HTB = HALF * BK * 2, NXCD = 8, WGM = 8;
__device__ __forceinline__ int lds_byte(int r, int c) { const int st = (r >> 4) * 2 + (c >> 5), rr = r & 15, cc = c & 31, ob = rr * 64 + cc * 2; return st * 1024 + (ob ^ (((ob >> 9) & 1) << 5)); }
__device__ __forceinline__ void stage_rc(int b, int& R, int& C) { const int st = b / 1024, sb = b % 1024, swz = sb ^ (((sb >> 9) & 1) << 5); R = (st >> 1) * 16 + swz / 64; C = (st & 1) * 32 + (swz % 64) / 2; }
__device__ __forceinline__ int perm32(int rho) { const int n = rho >> 4, i = rho & 15; return 8 * (i >> 2) + 4 * n + (i & 3); }
struct Unit { int pm, pn; };
struct Gemm { const bf16_t* A; const bf16_t* Bt; int lda, ldb, K; };
struct StaticOrder {
    int nM, nN, nwg, G, c;
    __device__ __forceinline__ void init(int M, int N, int G_, int c_) { nM = M / BM; nN = N / BM; nwg = nM * nN; G = G_; c = c_; }
    __device__ __forceinline__ bool next(int i, Unit& u) const {
        const long L = (long)i * G + c; if (L >= nwg) return false;
        int wgid = (int)L; { const int q = nwg / NXCD, r = nwg % NXCD, xcd = wgid % NXCD, off = wgid / NXCD; wgid = (xcd < r ? xcd * (q + 1) : r * (q + 1) + (xcd - r) * q) + off; }
        const int nig = WGM * nN, gid = wgid / nig, fm = gid * WGM, gsz = WGM;
        u.pm = fm + ((wgid % nig) % gsz); u.pn = (wgid % nig) / gsz; return true;
    }
};
struct MergeOrder {
    StaticOrder so;
    __device__ __forceinline__ bool next(int i, Unit& u) const { Unit t; if (!so.next(i >> 2, t)) return false; const int br = i & 3; u.pm = br * 64 + t.pm; u.pn = br * 4 + t.pn; return true; }
};
__device__ __forceinline__ unsigned cvt_pk_bf16(float lo, float hi) { unsigned r; asm volatile("v_cvt_pk_bf16_f32 %0, %1, %2" : "=v"(r) : "v"(lo), "v"(hi)); return r; }

struct EpiStoreBf16 {
    static constexpr bool PERM = true;
    bf16_t* O; int ldc;
    __device__ __forceinline__ void operator()(const f32x4 (&acc)[2][2][4][2], const Unit& u, int wr, int wc, int fr, int fq) const {
        const int row0 = u.pm * BM + wr * 64 + fr, col0 = u.pn * BM + wc * 32 + 8 * fq;
#pragma unroll
        for (int ai = 0; ai < 2; ++ai)
#pragma unroll
            for (int m = 0; m < 4; ++m) { bf16_t* rowp = O + (size_t)(row0 + ai * HALF + m * 16) * ldc + col0;
#pragma unroll
                for (int bj = 0; bj < 2; ++bj) { const f32x4 v0 = acc[ai][bj][m][0], v1 = acc[ai][bj][m][1];
                    u32x4 w; w.x = cvt_pk_bf16(v0[0], v0[1]); w.y = cvt_pk_bf16(v0[2], v0[3]); w.z = cvt_pk_bf16(v1[0], v1[1]); w.w = cvt_pk_bf16(v1[2], v1[3]);
                    *(u32x4*)(rowp + bj * HALF) = w; } }
    }
};
struct EpiResid {
    static constexpr bool PERM = false;
    float* X;
    __device__ __forceinline__ void operator()(const f32x4 (&acc)[2][2][4][2], const Unit& u, int wr, int wc, int fr, int fq) const {
        const int row0 = u.pm * BM + wr * 64 + fr, col0 = u.pn * BM + wc * 32 + 4 * fq;
#pragma unroll
        for (int ai = 0; ai < 2; ++ai) {
            f32x4 xv[4][2][2];
#pragma unroll
            for (int m = 0; m < 4; ++m) { const float* rowp = X + (size_t)(row0 + ai * HALF + m * 16) * DM + col0;
#pragma unroll
                for (int bj = 0; bj < 2; ++bj)
#pragma unroll
                    for (int n = 0; n < 2; ++n) xv[m][bj][n] = *(const f32x4*)(rowp + bj * HALF + n * 16); }
#pragma unroll
            for (int m = 0; m < 4; ++m) { float* rowp = X + (size_t)(row0 + ai * HALF + m * 16) * DM + col0;
#pragma unroll
                for (int bj = 0; bj < 2; ++bj)
#pragma unroll
                    for (int n = 0; n < 2; ++n) *(f32x4*)(rowp + bj * HALF + n * 16) = xv[m][bj][n] * ALPHA + acc[ai][bj][m][n]; }
            asm volatile("" ::: "memory");
        }
    }
};
struct EpiSwiglu {
    static constexpr bool PERM = true;
    bf16_t* H;
    __device__ __forceinline__ void operator()(const f32x4 (&acc)[2][2][4][2], const Unit& u, int wr, int wc, int fr, int fq) const {
        const int row0 = u.pm * BM + wr * 64 + fr, col0 = u.pn * HALF + wc * 32 + 8 * fq;
#pragma unroll
        for (int ai = 0; ai < 2; ++ai)
#pragma unroll
            for (int m = 0; m < 4; ++m) { bf16_t* rowp = H + (size_t)(row0 + ai * HALF + m * 16) * DFF + col0;
                float h[8];
#pragma unroll
                for (int n = 0; n < 2; ++n)
#pragma unroll
                    for (int j = 0; j < 4; ++j) { const float a = acc[ai][0][m][n][j], b = acc[ai][1][m][n][j]; h[n * 4 + j] = siluf_(a) * b; }
                u32x4 w; w.x = cvt_pk_bf16(h[0], h[1]); w.y = cvt_pk_bf16(h[2], h[3]); w.z = cvt_pk_bf16(h[4], h[5]); w.w = cvt_pk_bf16(h[6], h[7]);
                *(u32x4*)rowp = w; }
    }
};
struct EpiMerge {
    static constexpr bool PERM = true;
    const bf16_t* P; const float* gate_b; bf16_t* Mg;
    __device__ __forceinline__ void operator()(const f32x4 (&acc)[2][2][4][2], const Unit& u, int wr, int wc, int fr, int fq) const {
        const int br = u.pm >> 6, pm = u.pm & 63, pn = u.pn & 3;
        const int row0 = pm * BM + wr * 64 + fr, col0 = pn * BM + wc * 32 + 8 * fq;
#pragma unroll
        for (int bj = 0; bj < 2; ++bj) { const int col = col0 + bj * HALF;
            const f32x4 gb0 = *(const f32x4*)(gate_b + br * 1024 + col), gb1 = *(const f32x4*)(gate_b + br * 1024 + col + 4);
#pragma unroll
            for (int ai = 0; ai < 2; ++ai) {
                u32x4 gw[4], ov[4];
#pragma unroll
                for (int m = 0; m < 4; ++m) { const size_t row = (size_t)(row0 + ai * HALF + m * 16);
                    gw[m] = *(const u32x4*)(P + row * PLD + C_GATE + br * 1024 + col);
                    ov[m] = (u32x4){0u, 0u, 0u, 0u}; if (br > 0) ov[m] = *(const u32x4*)(Mg + row * DM + col); }
#pragma unroll
                for (int m = 0; m < 4; ++m) { const size_t row = (size_t)(row0 + ai * HALF + m * 16); const u32x4 g4 = gw[m], o = ov[m];
                    float v[8];
                    v[0] = sigmoidf_(bflo(g4.x) + gb0[0]) * acc[ai][bj][m][0][0] + bflo(o.x); v[1] = sigmoidf_(bfhi(g4.x) + gb0[1]) * acc[ai][bj][m][0][1] + bfhi(o.x);
                    v[2] = sigmoidf_(bflo(g4.y) + gb0[2]) * acc[ai][bj][m][0][2] + bflo(o.y); v[3] = sigmoidf_(bfhi(g4.y) + gb0[3]) * acc[ai][bj][m][0][3] + bfhi(o.y);
                    v[4] = sigmoidf_(bflo(g4.z) + gb1[0]) * acc[ai][bj][m][1][0] + bflo(o.z); v[5] = sigmoidf_(bfhi(g4.z) + gb1[1]) * acc[ai][bj][m][1][1] + bfhi(o.z);
                    v[6] = sigmoidf_(bflo(g4.w) + gb1[2]) * acc[ai][bj][m][1][2] + bflo(o.w); v[7] = sigmoidf_(bfhi(g4.w) + gb1[3]) * acc[ai][bj][m][1][3] + bfhi(o.w);
                    u32x4 w; w.x = cvt_pk_bf16(v[0], v[1]); w.y = cvt_pk_bf16(v[2], v[3]); w.z = cvt_pk_bf16(v[4], v[5]); w.w = cvt_pk_bf16(v[6], v[7]);
                    *(u32x4*)(Mg + row * DM + col) = w; }
                asm volatile("" ::: "memory"); }
            asm volatile("" ::: "memory"); }
    }
};

template <class Epi, class Sched>
__device__ __forceinline__ void gemm_phase(LAS unsigned char* lds, const Gemm g, const Sched& S, const Epi& E) {
    const int tid = otid(), wid = __builtin_amdgcn_readfirstlane(tid >> 6), lane = tid & 63, wr = wid >> 2, wc = wid & 3, fr = lane & 15, fq = lane >> 4;
    const int K = g.K, nt = K / BK;
    unsigned voffA[2], voffB[2];
#pragma unroll
    for (int i = 0; i < 2; ++i) { int R, C; stage_rc(tid * 16 + i * 8192, R, C); const int Rb = Epi::PERM ? ((R & ~31) + perm32(R & 31)) : R;
        voffA[i] = (unsigned)(R * g.lda + C) * 2u; voffB[i] = (unsigned)(Rb * g.ldb + C) * 2u; }
    const size_t kstep = (size_t)(BK * 2);
    const size_t hstepA = (size_t)HALF * g.lda * 2, hstepB = (size_t)HALF * g.ldb * 2;
    const size_t tstepA = 2 * hstepA, tstepB = 2 * hstepB;
    const unsigned ldsw = (unsigned)wid * 1024u;
    const int aoff = lds_byte(wr * 64 + fr, fq * 8), boff = lds_byte(wc * 32 + fr, fq * 8);
#define PG8_SA(b, h) (((b) * 2 + (h)) * HTB)
#define PG8_SB(b, h) ((4 + (b) * 2 + (h)) * HTB)
#define PG8_STAGE(bufoff, gbase, voff) do { _Pragma("unroll") for (int _i = 0; _i < 2; ++_i) \
        __builtin_amdgcn_global_load_lds((const unsigned*)((const char*)(gbase) + (voff)[_i]), (LAS unsigned*)(lds + (bufoff) + ldsw + _i * 8192), 16, 0, 0); } while (0)
#define PG8_LDA(dst, b, h) do { _Pragma("unroll") for (int m = 0; m < 4; ++m) _Pragma("unroll") for (int k = 0; k < 2; ++k) dst[m][k] = *(const LAS bf16x8*)(lds + PG8_SA(b, h) + aoff + m * 2048 + k * 1024); } while (0)
#define PG8_LDB(dst, b, h) do { _Pragma("unroll") for (int n = 0; n < 2; ++n) _Pragma("unroll") for (int k = 0; k < 2; ++k) dst[n][k] = *(const LAS bf16x8*)(lds + PG8_SB(b, h) + boff + n * 2048 + k * 1024); } while (0)
#define PG8_MMA(ai, bj, At, Bt) do { __builtin_amdgcn_s_setprio(1); _Pragma("unroll") for (int m = 0; m < 4; ++m) _Pragma("unroll") for (int n = 0; n < 2; ++n) _Pragma("unroll") for (int k = 0; k < 2; ++k) \
        acc[ai][bj][m][n] = __builtin_amdgcn_mfma_f32_16x16x32_bf16(Bt[n][k], At[m][k], acc[ai][bj][m][n], 0, 0, 0); __builtin_amdgcn_s_setprio(0); } while (0)
#define PG8_WAIT_V(n) asm volatile("s_waitcnt vmcnt(" #n ")" ::: "memory")
#define PG8_WAIT_L(n) asm volatile("s_waitcnt lgkmcnt(" #n ")" ::: "memory")
#define PG8_BAR __builtin_amdgcn_s_barrier()
#define PG8_SCHED __builtin_amdgcn_sched_barrier(0)
    Unit cur, nxt; int ui = 0;
    if (!S.next(0, cur)) return;
    f32x4 acc[2][2][4][2];
#pragma unroll
    for (int a = 0; a < 2; ++a)
#pragma unroll
        for (int b = 0; b < 2; ++b)
#pragma unroll
            for (int m = 0; m < 4; ++m)
#pragma unroll
                for (int n = 0; n < 2; ++n) acc[a][b][m][n] = (f32x4){0.f, 0.f, 0.f, 0.f};
    bf16x8 At[4][2], B0[2][2], B1[2][2];
    const char* cA = (const char*)g.A + (size_t)cur.pm * tstepA; const char* cB = (const char*)g.Bt + (size_t)cur.pn * tstepB;
    PG8_STAGE(PG8_SB(0, 0), cB, voffB); PG8_STAGE(PG8_SA(0, 0), cA, voffA); PG8_STAGE(PG8_SB(0, 1), cB + hstepB, voffB); PG8_STAGE(PG8_SA(0, 1), cA + hstepA, voffA);
    if (wr == 1) PG8_BAR;
    PG8_WAIT_V(4); PG8_BAR;
    PG8_STAGE(PG8_SB(1, 0), cB + kstep, voffB); PG8_STAGE(PG8_SA(1, 0), cA + kstep, voffA); PG8_STAGE(PG8_SB(1, 1), cB + hstepB + kstep, voffB);
    PG8_WAIT_V(6); PG8_BAR;
    for (;;) {
        const bool has_next = S.next(ui + 1, nxt);
        const char* nA = has_next ? (const char*)g.A + (size_t)nxt.pm * tstepA : cA; const char* nB = has_next ? (const char*)g.Bt + (size_t)nxt.pn * tstepB : cB;
#pragma unroll 1
        for (int t = 0; t < nt; t += 2) {
            const bool last = (t == nt - 2);
            const char* a1 = cA + (size_t)(t + 1) * kstep;
            const char* a2 = last ? nA : cA + (size_t)(t + 2) * kstep; const char* b2 = last ? nB : cB + (size_t)(t + 2) * kstep;
            const char* a3 = a2 + kstep; const char* b3 = b2 + kstep;
            PG8_LDB(B0, 0, 0); PG8_SCHED; PG8_LDA(At, 0, 0); PG8_STAGE(PG8_SA(1, 1), a1 + hstepA, voffA);
            PG8_WAIT_L(8); PG8_BAR; PG8_WAIT_L(0); PG8_MMA(0, 0, At, B0); PG8_BAR; PG8_SCHED;
            PG8_LDB(B1, 0, 1); PG8_STAGE(PG8_SB(0, 0), b2, voffB);
            PG8_BAR; PG8_WAIT_L(0); PG8_MMA(0, 1, At, B1); PG8_BAR;
            PG8_LDA(At, 0, 1); PG8_STAGE(PG8_SA(0, 0), a2, voffA);
            PG8_BAR; PG8_WAIT_L(0); PG8_MMA(1, 0, At, B0); PG8_BAR; PG8_SCHED;
            PG8_STAGE(PG8_SB(0, 1), b2 + hstepB, voffB);
            PG8_WAIT_V(6); PG8_BAR; PG8_MMA(1, 1, At, B1); PG8_BAR;
            PG8_LDB(B0, 1, 0); PG8_SCHED; PG8_LDA(At, 1, 0); PG8_STAGE(PG8_SA(0, 1), a2 + hstepA, voffA);
            PG8_WAIT_L(8); PG8_BAR; PG8_WAIT_L(0); PG8_MMA(0, 0, At, B0); PG8_BAR; PG8_SCHED;
            PG8_LDB(B1, 1, 1); PG8_STAGE(PG8_SB(1, 0), b3, voffB);
            PG8_BAR; PG8_WAIT_L(0); PG8_MMA(0, 1, At, B1); PG8_BAR;
            PG8_LDA(At, 1, 1); PG8_STAGE(PG8_SA(1, 0), a3, voffA);
            PG8_BAR; PG8_WAIT_L(0); PG8_MMA(1, 0, At, B0); PG8_BAR; PG8_SCHED;
            PG8_STAGE(PG8_SB(1, 1), b3 + hstepB, voffB);
            PG8_WAIT_V(6); PG8_BAR; PG8_MMA(1, 1, At, B1); PG8_BAR;
        }
        E(acc, cur, wr, wc, fr, fq);
        if (!has_next) break;
#pragma unroll
        for (int a = 0; a < 2; ++a)
#pragma unroll
            for (int b = 0; b < 2; ++b)
#pragma unroll
                for (int m = 0; m < 4; ++m)
#pragma unroll
                    for (int n = 0; n < 2; ++n) acc[a][b][m][n] = (f32x4){0.f, 0.f, 0.f, 0.f};
        cur = nxt; cA = nA; cB = nB; ++ui;
    }
    PG8_WAIT_V(0);
    if (wr == 0) PG8_BAR;
    PG8_BAR;
#undef PG8_SA
#undef PG8_SB
#undef PG8_STAGE
#undef PG8_LDA
#undef PG8_LDB
#undef PG8_MMA
#undef PG8_WAIT_V
#undef PG8_WAIT_L
#undef PG8_BAR
#undef PG8_SCHED
}
}

__device__ __forceinline__ void tconv_tile(LAS float* tile, const float* src, int ldS, int sc0, int scLimit, bf16_t* dst, int ldD, int dr0, int k0) {
    const int tid = otid();
    { const int r = tid >> 4, c4 = (tid & 15) * 4;
#pragma unroll
      for (int h = 0; h < 2; ++h) { const int k = r + 32 * h; f32x4 v = (f32x4){0.f, 0.f, 0.f, 0.f};
          if (sc0 + c4 < scLimit) v = *(const f32x4*)(src + (size_t)(k0 + k) * ldS + sc0 + c4);
          tile[k * 65 + c4 + 0] = v[0]; tile[k * 65 + c4 + 1] = v[1]; tile[k * 65 + c4 + 2] = v[2]; tile[k * 65 + c4 + 3] = v[3]; } }
    __syncthreads();
    { const int n = tid >> 3, kc = (tid & 7) * 8; float e[8];
#pragma unroll
      for (int i = 0; i < 8; ++i) e[i] = tile[(kc + i) * 65 + n];
      u32x4 w; w.x = pack2(e[0], e[1]); w.y = pack2(e[2], e[3]); w.z = pack2(e[4], e[5]); w.w = pack2(e[6], e[7]);
      *(u32x4*)(dst + (size_t)(dr0 + n) * ldD + k0 + kc) = w; }
    __syncthreads();
}

typedef const float* const __attribute__((address_space(4)))* kin_t;
struct Ctx {
    kin_t kin; unsigned char* ws; float* X; LAS unsigned char* lds; int G, bid;
    __device__ __forceinline__ const float* in(int k) const { int z = k; asm volatile("" : "+s"(z)); return kin[z]; }
#define WSP(name, T, off) __device__ __forceinline__ T* name() const { return (T*)(ws + (off)); }
    WSP(WinT, bf16_t, WS_WIN) WSP(UpT, bf16_t, WS_UP) WSP(WoutT, bf16_t, WS_WOUT) WSP(WqT, bf16_t, WS_WQ) WSP(WoT, bf16_t, WS_WO)
    WSP(FfuT, bf16_t, WS_FFU) WSP(FfdT, bf16_t, WS_FFD) WSP(KV, bf16_t, WS_KV) WSP(XB, bf16_t, WS_XB) WSP(Y, bf16_t, WS_Y)
    WSP(R, bf16_t, WS_R) WSP(KM, bf16_t, WS_KM) WSP(V, bf16_t, WS_V) WSP(AN, bf16_t, WS_AN) WSP(BN, bf16_t, WS_BN)
    WSP(P, bf16_t, WS_P) WSP(Gg, bf16_t, WS_XB + XB_G) WSP(Qb, bf16_t, WS_P + P_Q) WSP(Ob, bf16_t, WS_P + P_O) WSP(Hb, bf16_t, WS_P + P_H)
    WSP(Memb, bf16_t, WS_Y + Y_MEMB) WSP(WkvT, bf16_t, WS_Y + Y_WKV)
    WSP(LoraT, bf16_t, WS_LORA) WSP(KMAX, unsigned, WS_KMAX)
    WSP(DEC, float, WS_DEC) WSP(CF, float, WS_CF) WSP(YRAW, float, WS_XB + XB_YRAW) WSP(BON, float, WS_XB + XB_BON)
#undef WSP
};

__device__ __forceinline__ void convert_layer(const Ctx& c, int l) {
    LAS float* tile = (LAS float*)c.lds;
    { const float* w2 = c.in(5) + (size_t)l * 64 * 256; const float* a2 = c.in(7) + (size_t)l * 64 * 256; const float* g2 = c.in(8) + (size_t)l * 160 * 256; bf16_t* LT = c.LoraT();
      for (int i = c.bid * 512 + otid(); i < 288 * 256; i += c.G * 512) { const int k = i >> 8, n = i & 255;
          const float v = k < 64 ? w2[k * 256 + n] : (k < 128 ? a2[(k - 64) * 256 + n] : g2[(k - 128) * 256 + n]); LT[n * 288 + k] = f2bf(v); } }
    for (int t = c.bid; t < 4992; t += c.G) {
        if (t < 1856) { const int nt = t % 116, kt = t / 116; const int n0 = nt * 64;
            const float* src = c.in(2) + (size_t)l * 1024 * DIN;
            if (n0 < C_GATE) tconv_tile(tile, src, DIN, n0, 3124, c.WinT(), 1024, n0, kt * 64);
            else tconv_tile(tile, src, DIN, n0 - 204, DIN, c.WinT(), 1024, n0, kt * 64);
        } else if (t < 2112) { const int q = t - 1856, br = q >> 6, r = q & 63, nt = r & 15, kt = r >> 4;
            const float* srcu = br == 0 ? c.in(14) : (br == 1 ? c.in(19) : (br == 2 ? c.in(23) : c.in(25)));
            tconv_tile(tile, srcu + (size_t)l * 256 * 1024, 1024, nt * 64, 1024, c.UpT() + (size_t)br * 1024 * 256, 256, nt * 64, kt * 64);
        } else if (t < 2880) { const int q = t - 2112, w = q >> 8, r = q & 255, nt = r & 15, kt = r >> 4;
            const float* srcw = w == 0 ? c.in(27) : (w == 1 ? c.in(28) : c.in(31)); bf16_t* dst = w == 0 ? c.WoutT() : (w == 1 ? c.WqT() : c.WoT());
            tconv_tile(tile, srcw + (size_t)l * 1024 * 1024, 1024, nt * 64, 1024, dst, 1024, nt * 64, kt * 64);
        } else if (t < 4288) { const int q = t - 2880, nt = q % 88, kt = q / 88; const int n0 = nt * 64, u = n0 >> 8, r = n0 & 255;
            const float* src = (r < 128 ? c.in(32) : c.in(33)) + (size_t)l * 1024 * DFF;
            tconv_tile(tile, src, DFF, u * 128 + (r & 127), DFF, c.FfuT(), 1024, n0, kt * 64);
        } else { const int q = t - 4288, nt = q & 15, kt = q >> 4;
            tconv_tile(tile, c.in(34) + (size_t)l * DFF * 1024, 1024, nt * 64, 1024, c.FfdT(), DFF, nt * 64, kt * 64);
        }
    }
}

__device__ __forceinline__ void prepass(const Ctx& c) {
    const int gtid = c.bid * 512 + otid(), gsz = c.G * 512;
    { const f32x4* xs = (const f32x4*)c.in(0); f32x4* xd = (f32x4*)c.X; u32x2* xb = (u32x2*)c.XB();
      for (int i = gtid; i < NTOK * DM / 4; i += gsz) { const f32x4 v = xs[i]; xd[i] = v; u32x2 w; w.x = pack2(v[0], v[1]); w.y = pack2(v[2], v[3]); xb[i] = w; } }
    { const f32x4* ms = (const f32x4*)c.in(1); u32x2* mb = (u32x2*)c.Memb();
      for (int i = gtid; i < 2048 * DM / 4; i += gsz) { const f32x4 v = ms[i]; u32x2 w; w.x = pack2(v[0], v[1]); w.y = pack2(v[2], v[3]); mb[i] = w; } }
    LAS float* tile = (LAS float*)c.lds;
    for (int t = c.bid; t < 2048; t += c.G) {
        const int lw = t >> 8, r = t & 255, nt = r & 15, kt = r >> 4; const int l = lw >> 1, which = lw & 1;
        tconv_tile(tile, (which ? c.in(30) : c.in(29)) + (size_t)l * 1024 * 1024, 1024, nt * 64, 1024, c.WkvT(), 1024, lw * 1024 + nt * 64, kt * 64);
    }
    convert_layer(c, 0);
}

__device__ __forceinline__ void rw_prep_tile(const Ctx& c, int l, int tile) {
    const int tid = otid(), lane = tid & 63, wave = tid >> 6, r = lane & 15, g = lane >> 4;
    const int tok0 = tile * 64;
    LAS bf16_t* lin = (LAS bf16_t*)c.lds;
    const float* mu = c.in(3) + l * 1056;
    const bf16_t* P = c.P();
#pragma unroll
    for (int q = 0; q < 5; ++q) {
        const int pc = tid + 512 * q;
        if (pc < 64 * 36) {
            const int tk = pc / 36, j8 = pc - tk * 36; const int tok = tok0 + tk, col = C_LORA + j8 * 8;
            const u32x4 cu = *(const u32x4*)(P + (size_t)tok * PLD + col);
            u32x4 pr = (u32x4){0u, 0u, 0u, 0u}; if ((tok & (SEQ - 1)) != 0) pr = *(const u32x4*)(P + (size_t)(tok - 1) * PLD + col);
            const f32x4 m0 = *(const f32x4*)(mu + col), m1 = *(const f32x4*)(mu + col + 4);
            float v[8];
            v[0] = bflo(cu.x) + (bflo(pr.x) - bflo(cu.x)) * m0[0]; v[1] = bfhi(cu.x) + (bfhi(pr.x) - bfhi(cu.x)) * m0[1];
            v[2] = bflo(cu.y) + (bflo(pr.y) - bflo(cu.y)) * m0[2]; v[3] = bfhi(cu.y) + (bfhi(pr.y) - bfhi(cu.y)) * m0[3];
            v[4] = bflo(cu.z) + (bflo(pr.z) - bflo(cu.z)) * m1[0]; v[5] = bfhi(cu.z) + (bfhi(pr.z) - bfhi(cu.z)) * m1[1];
            v[6] = bflo(cu.w) + (bflo(pr.w) - bflo(cu.w)) * m1[2]; v[7] = bfhi(cu.w) + (bfhi(pr.w) - bfhi(cu.w)) * m1[3];
            if (j8 < 8) {
#pragma unroll
                for (int i = 0; i < 8; ++i) { const float e2 = __expf(2.f * v[i]); v[i] = 1.f - 2.f / (e2 + 1.f); }
            } else if (j8 >= 16) {
#pragma unroll
                for (int i = 0; i < 8; ++i) v[i] = sigmoidf_(v[i]);
            }
            u32x4 w; w.x = pack2(v[0], v[1]); w.y = pack2(v[2], v[3]); w.z = pack2(v[4], v[5]); w.w = pack2(v[6], v[7]);
            *(LAS u32x4*)(lin + tk * 296 + j8 * 8) = w;
        }
    }
    __syncthreads();
    const int h = wave & 3, th = wave >> 2;
    const bf16_t* LT = c.LoraT();
    f32x4 accW[2][4], accA[2][4], accG[2][4];
#pragma unroll
    for (int mt = 0; mt < 2; ++mt)
#pragma unroll
        for (int nt = 0; nt < 4; ++nt) { accW[mt][nt] = (f32x4){0.f, 0.f, 0.f, 0.f}; accA[mt][nt] = (f32x4){0.f, 0.f, 0.f, 0.f}; accG[mt][nt] = (f32x4){0.f, 0.f, 0.f, 0.f}; }
#pragma unroll
    for (int ks = 0; ks < 9; ++ks) {
        bf16x8 af[2];
#pragma unroll
        for (int mt = 0; mt < 2; ++mt) af[mt] = *(const LAS bf16x8*)(lin + (th * 32 + mt * 16 + r) * 296 + ks * 32 + 8 * g);
#pragma unroll
        for (int nt = 0; nt < 4; ++nt) {
            const int n = h * 64 + nt * 16 + r;
            const bf16x8 bfr = *(const bf16x8*)(LT + n * 288 + ks * 32 + 8 * g);
#pragma unroll
            for (int mt = 0; mt < 2; ++mt) {
                if (ks < 2) accW[mt][nt] = __builtin_amdgcn_mfma_f32_16x16x32_bf16(af[mt], bfr, accW[mt][nt], 0, 0, 0);
                else if (ks < 4) accA[mt][nt] = __builtin_amdgcn_mfma_f32_16x16x32_bf16(af[mt], bfr, accA[mt][nt], 0, 0, 0);
                else accG[mt][nt] = __builtin_amdgcn_mfma_f32_16x16x32_bf16(af[mt], bfr, accG[mt][nt], 0, 0, 0);
            }
        }
    }
    const float* w0 = c.in(4) + l * 256; const float* a0 = c.in(6) + l * 256; const float* kkp = c.in(9) + l * 256; const float* kap = c.in(10) + l * 256; const float* rkp = c.in(11) + l * 256;
    float w0v[4], a0v[4], kkv[4], kav[4], rkv[4], mur[4], muk[4], muv[4];
#pragma unroll
    for (int nt = 0; nt < 4; ++nt) { const int n = h * 64 + nt * 16 + r; w0v[nt] = w0[n]; a0v[nt] = a0[n]; kkv[nt] = kkp[n]; kav[nt] = kap[n]; rkv[nt] = rkp[n]; mur[nt] = mu[C_RWR + n]; muk[nt] = mu[C_RWK + n]; muv[nt] = mu[C_RWV + n]; }
#pragma unroll
    for (int mt = 0; mt < 2; ++mt)
#pragma unroll
        for (int reg = 0; reg < 4; ++reg) {
            const int tok = tok0 + th * 32 + mt * 16 + 4 * g + reg; const bool first = (tok & (SEQ - 1)) == 0;
            const bf16_t* pc = P + (size_t)tok * PLD; const bf16_t* pp = pc - PLD;
            float ssk = 0.f, bon = 0.f, kkn[4], av[4];
#pragma unroll
            for (int nt = 0; nt < 4; ++nt) {
                const int n = h * 64 + nt * 16 + r;
                const float cr = bf2f(pc[C_RWR + n]), ck = bf2f(pc[C_RWK + n]), cv = bf2f(pc[C_RWV + n]);
                const float qr = first ? 0.f : bf2f(pp[C_RWR + n]), qk = first ? 0.f : bf2f(pp[C_RWK + n]), qv = first ? 0.f : bf2f(pp[C_RWV + n]);
                const float rr = cr + (qr - cr) * mur[nt], kx = ck + (qk - ck) * muk[nt], vx = cv + (qv - cv) * muv[nt];
                const float pre = w0v[nt] + accW[mt][nt][reg];
                const float wlog = logsigf_(pre) - 0.5f;
                const float dec = __expf(-__expf(wlog));
                const float a = sigmoidf_(a0v[nt] + accA[mt][nt][reg]);
                const float kk_ = kx * kkv[nt]; ssk += kk_ * kk_;
                const float km = kx * (1.f + (a - 1.f) * kav[nt]);
                bon += rr * km * rkv[nt];
                const size_t o = (size_t)tok * 256 + n;
                c.DEC()[o] = dec; c.R()[o] = f2bf(rr); c.KM()[o] = f2bf(km); c.V()[o] = f2bf(vx); c.Gg()[o] = f2bf(accG[mt][nt][reg]);
                kkn[nt] = kk_; av[nt] = a;
            }
            ssk = rsum16(ssk); bon = rsum16(bon);
            const float inv = 1.f / fmaxf(sqrtf(ssk), 1e-12f);
#pragma unroll
            for (int nt = 0; nt < 4; ++nt) { const size_t o = (size_t)tok * 256 + h * 64 + nt * 16 + r; const float kn = kkn[nt] * inv; c.AN()[o] = f2bf(-kn); c.BN()[o] = f2bf(kn * av[nt]); }
            if (r == 0) c.BON()[(size_t)tok * 4 + h] = bon;
        }
    __syncthreads();
}

__device__ __forceinline__ void conv_tile(const Ctx& c, int l, int tile) {
    const int tid = otid(), lane = tid & 63, wave = tid >> 6;
    const int tok0 = tile * 32, t0 = tok0 & (SEQ - 1);
    LAS float* ub = (LAS float*)c.lds;
    LAS float* ob = ub + 62 * 256;
    const bf16_t* P = c.P();
#pragma unroll
    for (int q = 0; q < 4; ++q) {
        const int pc = tid + 512 * q;
        if (pc < 62 * 32) {
            const int row = pc >> 5, c8 = (pc & 31) * 8;
            f32x4 o0 = (f32x4){0.f, 0.f, 0.f, 0.f}, o1 = (f32x4){0.f, 0.f, 0.f, 0.f};
            if (t0 - 30 + row >= 0) { const size_t tok = (size_t)(tok0 - 30 + row);
                const u32x4 a = *(const u32x4*)(P + tok * PLD + C_CVA + c8), b = *(const u32x4*)(P + tok * PLD + C_CVB + c8);
                o0[0] = bflo(a.x) * sigmoidf_(bflo(b.x)); o0[1] = bfhi(a.x) * sigmoidf_(bfhi(b.x)); o0[2] = bflo(a.y) * sigmoidf_(bflo(b.y)); o0[3] = bfhi(a.y) * sigmoidf_(bfhi(b.y));
                o1[0] = bflo(a.z) * sigmoidf_(bflo(b.z)); o1[1] = bfhi(a.z) * sigmoidf_(bfhi(b.z)); o1[2] = bflo(a.w) * sigmoidf_(bflo(b.w)); o1[3] = bfhi(a.w) * sigmoidf_(bfhi(b.w)); }
            *(LAS f32x4*)(ub + row * 256 + c8) = o0; *(LAS f32x4*)(ub + row * 256 + c8 + 4) = o1;
        }
    }
    __syncthreads();
    { const int ch = tid & 255, tg = tid >> 8;
      const float* cw_ = c.in(15) + (size_t)l * 31 * 256; float cw[31];
#pragma unroll
      for (int w = 0; w < 31; ++w) cw[w] = cw_[w * 256 + ch];
      const float bias = c.in(16)[l * 256 + ch];
      for (int tt = 0; tt < 16; ++tt) { const int tl = tg * 16 + tt; float acc = bias;
#pragma unroll
          for (int w = 0; w < 31; ++w) acc += ub[(tl + w) * 256 + ch] * cw[w];
          ob[tl * 256 + ch] = acc; } }
    __syncthreads();
    { const f32x4 gv = *(const f32x4*)(c.in(17) + l * 256 + 4 * lane), bv = *(const f32x4*)(c.in(18) + l * 256 + 4 * lane);
      bf16_t* Yc = c.Y() + (size_t)1 * NTOK * 256;
      for (int q = 0; q < 4; ++q) { const int tl = wave * 4 + q;
          const f32x4 x = *(const LAS f32x4*)(ob + tl * 256 + 4 * lane);
          const float mean = wsum64((x[0] + x[1]) + (x[2] + x[3])) * (1.f / 256.f);
          const f32x4 d = x - mean;
          const float var = wsum64((d[0] * d[0] + d[1] * d[1]) + (d[2] * d[2] + d[3] * d[3])) * (1.f / 256.f);
          const float rstd = rsqrtf(var + LN_EPS);
          f32x4 y = d * rstd * gv + bv;
          u32x2 w; w.x = pack2(siluf_(y[0]), siluf_(y[1])); w.y = pack2(siluf_(y[2]), siluf_(y[3]));
          *(u32x2*)(Yc + (size_t)(tok0 + tl) * 256 + 4 * lane) = w; } }
    __syncthreads();
}

__device__ __forceinline__ void fox_cumsum(const Ctx& c, int l, int b) {
    const int tid = otid(), lane = tid & 63, wave = tid >> 6;
    LAS float* wt = (LAS float*)c.lds;
    const f32x4 bf = *(const f32x4*)(c.in(24) + l * 4);
    f32x4 pre[4]; f32x4 run = (f32x4){0.f, 0.f, 0.f, 0.f};
#pragma unroll
    for (int i = 0; i < 4; ++i) { const size_t tok = (size_t)b * SEQ + tid * 4 + i; const u32x2 z = *(const u32x2*)(c.P() + tok * PLD + C_FZ);
        run[0] += logsigf_(bflo(z.x) + bf[0]); run[1] += logsigf_(bfhi(z.x) + bf[1]); run[2] += logsigf_(bflo(z.y) + bf[2]); run[3] += logsigf_(bfhi(z.y) + bf[3]); pre[i] = run; }
    f32x4 inc = run;
#pragma unroll
    for (int off = 1; off < 64; off <<= 1) {
#pragma unroll
        for (int hh = 0; hh < 4; ++hh) { const float t = __shfl_up(inc[hh], off); if (lane >= off) inc[hh] += t; } }
    if (lane == 63) { wt[wave * 4 + 0] = inc[0]; wt[wave * 4 + 1] = inc[1]; wt[wave * 4 + 2] = inc[2]; wt[wave * 4 + 3] = inc[3]; }
    __syncthreads();
    f32x4 base = inc - run;
    for (int w = 0; w < wave; ++w) { base[0] += wt[w * 4 + 0]; base[1] += wt[w * 4 + 1]; base[2] += wt[w * 4 + 2]; base[3] += wt[w * 4 + 3]; }
#pragma unroll
    for (int i = 0; i < 4; ++i) { const size_t tok = (size_t)b * SEQ + tid * 4 + i; *(f32x4*)(c.CF() + tok * 4) = pre[i] + base; }
    __syncthreads();
}

__device__ __forceinline__ void rw_scan_item(const Ctx& c, int item) {
    const int tid = otid(), lane = tid & 63, wave = __builtin_amdgcn_readfirstlane(tid >> 6);
    const int qr = item & 3, h = (item >> 2) & 3, b = item >> 4;
    const int cb = h * 64, rb = qr * 16; const size_t tokb = (size_t)b * SEQ;
    LAS float* L = (LAS float*)c.lds;
    constexpr int BUFSZ = 10752;
    LAS float* ybase = L + 2 * BUFSZ;
    constexpr int NCH = SEQ / 32;
    if (wave < 4) {
        const int jg = lane & 15, rA = wave * 4 + (lane >> 4);
        f32x2 SaA = (f32x2){0.f, 0.f}, SbA = (f32x2){0.f, 0.f};
        __syncthreads();
        for (int cc = 0; cc < NCH; ++cc) {
            const LAS float* buf = L + (cc & 1) * BUFSZ; LAS float* ybuf = ybase + (cc & 1) * 512;
            const LAS float* bj = buf + 4 * jg; const LAS float* bv = buf + 10240 + rA;
            f32x4 w4 = *(const LAS f32x4*)(bj), k4 = *(const LAS f32x4*)(bj + 2048), a4 = *(const LAS f32x4*)(bj + 4096), b4 = *(const LAS f32x4*)(bj + 6144), r4 = *(const LAS f32x4*)(bj + 8192);
            float vi = bv[0], ykA = 0.f;
#pragma unroll
            for (int st = 0; st < 32; ++st) {
                const f32x4 nw4 = *(const LAS f32x4*)(bj + (st + 1) * 64), nk4 = *(const LAS f32x4*)(bj + 2048 + (st + 1) * 64), na4 = *(const LAS f32x4*)(bj + 4096 + (st + 1) * 64),
                            nb4 = *(const LAS f32x4*)(bj + 6144 + (st + 1) * 64), nr4 = *(const LAS f32x4*)(bj + 8192 + (st + 1) * 64);
                const float nvi = bv[(st + 1) * 16];
                const f32x2 a01 = (f32x2){a4[0], a4[1]}, a23 = (f32x2){a4[2], a4[3]}, w01 = (f32x2){w4[0], w4[1]}, w23 = (f32x2){w4[2], w4[3]}, k01 = (f32x2){k4[0], k4[1]}, k23 = (f32x2){k4[2], k4[3]};
                const f32x2 b01 = (f32x2){b4[0], b4[1]}, b23 = (f32x2){b4[2], b4[3]}, r01 = (f32x2){r4[0], r4[1]}, r23 = (f32x2){r4[2], r4[3]};
                const f32x2 dA = SaA * a01 + SbA * a23;
                const f32x2 taA = SaA * w01 + vi * k01, tbA = SbA * w23 + vi * k23;
                const float saA = dsum16(dA.x + dA.y);
                SaA = saA * b01 + taA; SbA = saA * b23 + tbA;
                const f32x2 yA2 = SaA * r01 + SbA * r23;
                const float yA = dsum16(yA2.x + yA2.y);
                ykA = ((st & 15) == jg) ? yA : ykA;
                if ((st & 15) == 15) ybuf[(st - 15 + jg) * 16 + rA] = ykA;
                w4 = nw4; k4 = nk4; a4 = na4; b4 = nb4; r4 = nr4; vi = nvi;
            }
            __syncthreads();
        }
        __syncthreads();
    } else {
        const int ft = tid - 256;
        f32x4 sd[2]; u32x4 sk, sa, sb, sr, sv;
#define RW_LOAD(cc_) do { const size_t tb_ = tokb + (size_t)(cc_) * 32; \
            _Pragma("unroll") for (int q = 0; q < 2; ++q) { const int pc = ft + 256 * q; sd[q] = *(const f32x4*)(c.DEC() + (tb_ + (pc >> 4)) * 256 + cb + (pc & 15) * 4); } \
            { const size_t o_ = (tb_ + (ft >> 3)) * 256 + cb + (ft & 7) * 8; sk = *(const u32x4*)(c.KM() + o_); sa = *(const u32x4*)(c.AN() + o_); sb = *(const u32x4*)(c.BN() + o_); sr = *(const u32x4*)(c.R() + o_); } \
            if (ft < 64) sv = *(const u32x4*)(c.V() + (tb_ + (ft >> 1)) * 256 + cb + rb + (ft & 1) * 8); } while (0)
#define RW_PUT8(dst, v_) do { *(LAS f32x4*)(dst) = (f32x4){bflo((v_).x), bfhi((v_).x), bflo((v_).y), bfhi((v_).y)}; *(LAS f32x4*)((dst) + 4) = (f32x4){bflo((v_).z), bfhi((v_).z), bflo((v_).w), bfhi((v_).w)}; } while (0)
#define RW_STAGE(cc_) do { LAS float* B_ = L + ((cc_) & 1) * BUFSZ; \
            _Pragma("unroll") for (int q = 0; q < 2; ++q) { const int pc = ft + 256 * q; *(LAS f32x4*)(B_ + (pc >> 4) * 64 + (pc & 15) * 4) = sd[q]; } \
            { LAS float* d_ = B_ + (ft >> 3) * 64 + (ft & 7) * 8; RW_PUT8(d_ + 2048, sk); RW_PUT8(d_ + 4096, sa); RW_PUT8(d_ + 6144, sb); RW_PUT8(d_ + 8192, sr); } \
            if (ft < 64) { LAS float* d_ = B_ + 10240 + (ft >> 1) * 16 + (ft & 1) * 8; RW_PUT8(d_, sv); } } while (0)
#define RW_YOUT(cc_) do { if (ft < 128) { const f32x4 y_ = *(const LAS f32x4*)(ybase + ((cc_) & 1) * 512 + (ft >> 2) * 16 + (ft & 3) * 4); \
            *(f32x4*)(c.YRAW() + (tokb + (size_t)(cc_) * 32 + (ft >> 2)) * 256 + cb + rb + (ft & 3) * 4) = y_; } } while (0)
        RW_LOAD(0); RW_STAGE(0); RW_LOAD(1);
        __syncthreads();
        for (int cc = 0; cc < NCH; ++cc) {
            if (cc + 1 < NCH) RW_STAGE(cc + 1);
            if (cc + 2 < NCH) RW_LOAD(cc + 2);
            if (cc > 0) RW_YOUT(cc - 1);
            __syncthreads();
        }
        RW_YOUT(NCH - 1);
        __syncthreads();
#undef RW_LOAD
#undef RW_PUT8
#undef RW_STAGE
#undef RW_YOUT
    }
}

__device__ __forceinline__ void gla_item(const Ctx& c, int l, int item) {
    const int tid = otid(), lane = tid & 63, wave = __builtin_amdgcn_readfirstlane(tid >> 6);
    const int h = item & 3, b = item >> 2; const size_t tokb = (size_t)b * SEQ;
    LAS float* L = (LAS float*)c.lds;
    LAS float* obase = L + 2 * 10240;
    const bf16_t* P = c.P();
    bf16_t* Yg = c.Y() + (size_t)2 * NTOK * 256;
    constexpr int NCH = SEQ / 64;
    if (wave < 4) {
        const int vl = lane >> 3, dq = lane & 7;
        f32x2 Sa0 = (f32x2){0.f, 0.f}, Sb0 = (f32x2){0.f, 0.f}, Sa1 = (f32x2){0.f, 0.f}, Sb1 = (f32x2){0.f, 0.f};
        __syncthreads();
        for (int cc = 0; cc < NCH; ++cc) {
            const LAS float* B = L + (cc & 1) * 10240; LAS float* ob = obase + (cc & 1) * 4096;
            const LAS float* pq = B + 4 * dq; const LAS float* pk = B + 2048 + 4 * dq; const LAS float* pa = B + 4096 + 4 * dq; const LAS float* pv = B + 6144 + wave * 16 + 2 * vl;
            f32x4 a4 = *(const LAS f32x4*)pa, k4 = *(const LAS f32x4*)pk, q4 = *(const LAS f32x4*)pq; f32x2 vv = *(const LAS f32x2*)pv; float ok0 = 0.f, ok1 = 0.f;
#pragma unroll 16
            for (int st = 0; st < 64; ++st) {
                const int sn = (st + 1) & 63;
                const f32x4 na4 = *(const LAS f32x4*)(pa + sn * 32), nk4 = *(const LAS f32x4*)(pk + sn * 32), nq4 = *(const LAS f32x4*)(pq + sn * 32); const f32x2 nvv = *(const LAS f32x2*)(pv + sn * 64);
                const f32x2 a01 = (f32x2){a4[0], a4[1]}, a23 = (f32x2){a4[2], a4[3]}, k01 = (f32x2){k4[0], k4[1]}, k23 = (f32x2){k4[2], k4[3]}, q01 = (f32x2){q4[0], q4[1]}, q23 = (f32x2){q4[2], q4[3]};
                Sa0 = Sa0 * a01 + vv.x * k01; Sb0 = Sb0 * a23 + vv.x * k23;
                Sa1 = Sa1 * a01 + vv.y * k01; Sb1 = Sb1 * a23 + vv.y * k23;
                const f32x2 o0 = Sa0 * q01 + Sb0 * q23, o1 = Sa1 * q01 + Sb1 * q23;
                const float r0 = dsum8(o0.x + o0.y), r1 = dsum8(o1.x + o1.y);
                ok0 = ((st & 7) == dq) ? r0 : ok0; ok1 = ((st & 7) == dq) ? r1 : ok1;
                if ((st & 7) == 7) *(LAS f32x2*)(ob + (st - 7 + dq) * 64 + wave * 16 + 2 * vl) = (f32x2){ok0, ok1};
                a4 = na4; k4 = nk4; q4 = nq4; vv = nvv;
            }
            __syncthreads();
        }
        __syncthreads();
    } else {
        const int ft = tid - 256;
        const float* a2 = c.in(20) + (size_t)l * 16 * 128; const float* ab = c.in(21) + l * 128;
        float a2c[16];
#pragma unroll
        for (int j = 0; j < 16; ++j) a2c[j] = a2[j * 128 + h * 32 + (ft & 31)];
        const float abv = ab[h * 32 + (ft & 31)];
        const int nvq = ft & 3;
        f32x4 lg[4];
#pragma unroll
        for (int i = 0; i < 4; ++i) lg[i] = *(const f32x4*)(c.in(22) + l * 256 + h * 64 + nvq * 16 + 4 * i);
        u32x4 rq, rk, rv[2];
#define GLA_LOAD(cc_) do { const size_t tb_ = tokb + (size_t)(cc_) * 64; \
            rq = *(const u32x4*)(P + (tb_ + (ft >> 2)) * PLD + C_GQ + h * 32 + (ft & 3) * 8); rk = *(const u32x4*)(P + (tb_ + (ft >> 2)) * PLD + C_GK + h * 32 + (ft & 3) * 8); \
            _Pragma("unroll") for (int q = 0; q < 2; ++q) { const int pc = ft + 256 * q; rv[q] = *(const u32x4*)(P + (tb_ + (pc >> 3)) * PLD + C_GV + h * 64 + (pc & 7) * 8); } } while (0)
#define GLA_STAGE(cc_) do { LAS float* B_ = L + ((cc_) & 1) * 10240; const size_t tb_ = tokb + (size_t)(cc_) * 64; const float qsc = 0.17677669529663687f; \
            { LAS float* d_ = B_ + (ft >> 2) * 32 + (ft & 3) * 8; \
              *(LAS f32x4*)d_ = (f32x4){bflo(rq.x) * qsc, bfhi(rq.x) * qsc, bflo(rq.y) * qsc, bfhi(rq.y) * qsc}; *(LAS f32x4*)(d_ + 4) = (f32x4){bflo(rq.z) * qsc, bfhi(rq.z) * qsc, bflo(rq.w) * qsc, bfhi(rq.w) * qsc}; \
              *(LAS f32x4*)(d_ + 2048) = (f32x4){bflo(rk.x), bfhi(rk.x), bflo(rk.y), bfhi(rk.y)}; *(LAS f32x4*)(d_ + 2052) = (f32x4){bflo(rk.z), bfhi(rk.z), bflo(rk.w), bfhi(rk.w)}; } \
            _Pragma("unroll") for (int q = 0; q < 2; ++q) { const int pc = ft + 256 * q; LAS float* d_ = B_ + 6144 + (pc >> 3) * 64 + (pc & 7) * 8; \
              *(LAS f32x4*)d_ = (f32x4){bflo(rv[q].x), bfhi(rv[q].x), bflo(rv[q].y), bfhi(rv[q].y)}; *(LAS f32x4*)(d_ + 4) = (f32x4){bflo(rv[q].z), bfhi(rv[q].z), bflo(rv[q].w), bfhi(rv[q].w)}; } \
              \
            _Pragma("unroll") for (int i = 0; i < 8; ++i) { const int t_ = (ft >> 5) * 8 + i; const bf16_t* gp = P + (tb_ + t_) * PLD + C_GZ; \
              const u32x4 z0 = *(const u32x4*)gp, z1 = *(const u32x4*)(gp + 8); \
              float z = abv; \
              z += bflo(z0.x) * a2c[0] + bfhi(z0.x) * a2c[1] + bflo(z0.y) * a2c[2] + bfhi(z0.y) * a2c[3] + bflo(z0.z) * a2c[4] + bfhi(z0.z) * a2c[5] + bflo(z0.w) * a2c[6] + bfhi(z0.w) * a2c[7]; \
              z += bflo(z1.x) * a2c[8] + bfhi(z1.x) * a2c[9] + bflo(z1.y) * a2c[10] + bfhi(z1.y) * a2c[11] + bflo(z1.z) * a2c[12] + bfhi(z1.z) * a2c[13] + bflo(z1.w) * a2c[14] + bfhi(z1.w) * a2c[15]; \
              B_[4096 + t_ * 32 + (ft & 31)] = __expf(logsigf_(z) * (1.f / 16.f)); } } while (0)
#define GLA_NORM(cc_) do { const LAS float* ob_ = obase + ((cc_) & 1) * 4096 + (ft >> 2) * 64 + nvq * 16; const size_t tok_ = tokb + (size_t)(cc_) * 64 + (ft >> 2); \
            const bf16_t* gp_ = P + tok_ * PLD + C_GR + h * 64 + nvq * 16; const u32x4 g0 = *(const u32x4*)gp_, g1 = *(const u32x4*)(gp_ + 8); \
            f32x4 o_[4]; float ss = 0.f; \
            _Pragma("unroll") for (int i = 0; i < 4; ++i) { o_[i] = *(const LAS f32x4*)(ob_ + 4 * i); ss += (o_[i][0] * o_[i][0] + o_[i][1] * o_[i][1]) + (o_[i][2] * o_[i][2] + o_[i][3] * o_[i][3]); } \
            ss += dpp_mov<0xB1>(ss); ss += dpp_mov<0x4E>(ss); \
            const float rs = rsqrtf(ss * (1.f / 64.f) + 1e-5f); \
            u32x4 w0, w1; \
            w0.x = pack2(o_[0][0] * rs * lg[0][0] * siluf_(bflo(g0.x)), o_[0][1] * rs * lg[0][1] * siluf_(bfhi(g0.x))); w0.y = pack2(o_[0][2] * rs * lg[0][2] * siluf_(bflo(g0.y)), o_[0][3] * rs * lg[0][3] * siluf_(bfhi(g0.y))); \
            w0.z = pack2(o_[1][0] * rs * lg[1][0] * siluf_(bflo(g0.z)), o_[1][1] * rs * lg[1][1] * siluf_(bfhi(g0.z))); w0.w = pack2(o_[1][2] * rs * lg[1][2] * siluf_(bflo(g0.w)), o_[1][3] * rs * lg[1][3] * siluf_(bfhi(g0.w))); \
            w1.x = pack2(o_[2][0] * rs * lg[2][0] * siluf_(bflo(g1.x)), o_[2][1] * rs * lg[2][1] * siluf_(bfhi(g1.x))); w1.y = pack2(o_[2][2] * rs * lg[2][2] * siluf_(bflo(g1.y)), o_[2][3] * rs * lg[2][3] * siluf_(bfhi(g1.y))); \
            w1.z = pack2(o_[3][0] * rs * lg[3][0] * siluf_(bflo(g1.z)), o_[3][1] * rs * lg[3][1] * siluf_(bfhi(g1.z))); w1.w = pack2(o_[3][2] * rs * lg[3][2] * siluf_(bflo(g1.w)), o_[3][3] * rs * lg[3][3] * siluf_(bfhi(g1.w))); \
            bf16_t* yp_ = Yg + tok_ * 256 + h * 64 + nvq * 16; *(u32x4*)yp_ = w0; *(u32x4*)(yp_ + 8) = w1; } while (0)
        GLA_LOAD(0); GLA_STAGE(0); GLA_LOAD(1);
        __syncthreads();
        for (int cc = 0; cc < NCH; ++cc) {
            if (cc + 1 < NCH) GLA_STAGE(cc + 1);
            if (cc + 2 < NCH) GLA_LOAD(cc + 2);
            if (cc > 0) GLA_NORM(cc - 1);
            __syncthreads();
        }
        GLA_NORM(NCH - 1);
        __syncthreads();
#undef GLA_LOAD
#undef GLA_STAGE
#undef GLA_NORM
    }
}

template <int D, bool FOX>
__device__ __forceinline__ void attn_block(LAS unsigned char* lds, const bf16_t* Q, int ldq, const bf16_t* Kp, int ldk, const bf16_t* Vp, int ldv,
                                           bf16_t* O, int ldo, int q0, int nkeys, float scale, const float* cvec) {
    constexpr int KLD = D + 8, VLD = 72, NKS = D / 32, NDT = D / 16;
    const int tid = otid(), lane = tid & 63, wave = tid >> 6, r = lane & 15, g = lane >> 4;
    LAS bf16_t* Ks = (LAS bf16_t*)lds;
    LAS bf16_t* Vt = Ks + 64 * KLD;
    LAS float* ckb = (LAS float*)(Vt + D * VLD);
    const int qrow = q0 + 16 * wave + r;
    bf16x8 Qf[NKS];
#pragma unroll
    for (int ks = 0; ks < NKS; ++ks) Qf[ks] = *(const bf16x8*)(Q + (size_t)qrow * ldq + ks * 32 + 8 * g);
    float cq = 0.f; if (FOX) cq = cvec[(size_t)qrow * 4];
    f32x4 Oacc[NDT];
#pragma unroll
    for (int dt = 0; dt < NDT; ++dt) Oacc[dt] = (f32x4){0.f, 0.f, 0.f, 0.f};
    float mrun = -1e30f, lsum = 0.f;
    const int nch = nkeys / 64;
    constexpr int NQ = (64 * D / 8) / 512;
    u32x4 kreg[NQ], vreg[NQ]; float ckr = 0.f;
#define ATT_LOAD(chn) do { const int k0_ = (chn) * 64; \
        _Pragma("unroll") for (int q = 0; q < NQ; ++q) { const int pidx = tid + 512 * q; const int key = pidx / (D / 8), dc = pidx % (D / 8); \
            kreg[q] = *(const u32x4*)(Kp + (size_t)(k0_ + key) * ldk + dc * 8); vreg[q] = *(const u32x4*)(Vp + (size_t)(k0_ + key) * ldv + dc * 8); } \
        if (FOX) { if (tid < 64) ckr = cvec[(size_t)(k0_ + tid) * 4]; } } while (0)
    ATT_LOAD(0);
    for (int ch = 0; ch < nch; ++ch) {
        const int key0 = ch * 64;
#pragma unroll
        for (int q = 0; q < NQ; ++q) { const int pidx = tid + 512 * q; const int key = pidx / (D / 8), dc = pidx % (D / 8);
            *(LAS u32x4*)(Ks + key * KLD + dc * 8) = kreg[q];
            const u32x4 vv = vreg[q];
            LAS bf16_t* vd = Vt + (dc * 8) * VLD + (key ^ ((dc & 15) << 2));
            vd[0 * VLD] = (bf16_t)(vv.x & 0xffff); vd[1 * VLD] = (bf16_t)(vv.x >> 16); vd[2 * VLD] = (bf16_t)(vv.y & 0xffff); vd[3 * VLD] = (bf16_t)(vv.y >> 16);
            vd[4 * VLD] = (bf16_t)(vv.z & 0xffff); vd[5 * VLD] = (bf16_t)(vv.z >> 16); vd[6 * VLD] = (bf16_t)(vv.w & 0xffff); vd[7 * VLD] = (bf16_t)(vv.w >> 16); }
        if (FOX) { if (tid < 64) ckb[tid] = ckr; }
        __syncthreads();
        if (ch + 1 < nch) ATT_LOAD(ch + 1);
        const bool active = !FOX || (key0 <= q0 + 16 * wave + 15);
        if (active) {
            f32x4 s[4];
#pragma unroll
            for (int kt = 0; kt < 4; ++kt) { f32x4 a = (f32x4){0.f, 0.f, 0.f, 0.f};
#pragma unroll
                for (int ks = 0; ks < NKS; ++ks) { const bf16x8 kf = *(const LAS bf16x8*)(Ks + (kt * 16 + r) * KLD + ks * 32 + 8 * g);
                    a = __builtin_amdgcn_mfma_f32_16x16x32_bf16(kf, Qf[ks], a, 0, 0, 0); }
                s[kt] = a; }
            float mx = -1e30f;
#pragma unroll
            for (int kt = 0; kt < 4; ++kt)
#pragma unroll
                for (int reg = 0; reg < 4; ++reg) { float v = s[kt][reg] * scale;
                    if (FOX) { const int kl = kt * 16 + 4 * g + reg; v += cq - ckb[kl]; if (key0 + kl > qrow) v = -1e30f; }
                    s[kt][reg] = v; mx = fmaxf(mx, v); }
            mx = fmaxf(mx, __shfl_xor(mx, 16)); mx = fmaxf(mx, __shfl_xor(mx, 32));
            const float mnew = fmaxf(mrun, mx); const float corr = __expf(mrun - mnew); mrun = mnew;
            float ps = 0.f;
#pragma unroll
            for (int kt = 0; kt < 4; ++kt)
#pragma unroll
                for (int reg = 0; reg < 4; ++reg) { const float pv = __expf(s[kt][reg] - mnew); s[kt][reg] = pv; ps += pv; }
            lsum = lsum * corr + ps;
            bf16x8 pf[2];
#pragma unroll
            for (int s2 = 0; s2 < 2; ++s2) {
                u32x4 w; w.x = pack2(s[2 * s2][0], s[2 * s2][1]); w.y = pack2(s[2 * s2][2], s[2 * s2][3]); w.z = pack2(s[2 * s2 + 1][0], s[2 * s2 + 1][1]); w.w = pack2(s[2 * s2 + 1][2], s[2 * s2 + 1][3]);
                pf[s2] = __builtin_bit_cast(bf16x8, w); }
#pragma unroll
            for (int dt = 0; dt < NDT; ++dt) { f32x4 o = Oacc[dt] * corr;
#pragma unroll
                for (int s2 = 0; s2 < 2; ++s2) { const int sw = ((dt * 2 + (r >> 3)) & 15) << 2; const LAS bf16_t* vrow = Vt + (dt * 16 + r) * VLD;
                    const u32x2 lo = *(const LAS u32x2*)(vrow + ((s2 * 32 + 4 * g) ^ sw)), hi = *(const LAS u32x2*)(vrow + ((s2 * 32 + 16 + 4 * g) ^ sw));
                    u32x4 w; w.x = lo.x; w.y = lo.y; w.z = hi.x; w.w = hi.y;
                    o = __builtin_amdgcn_mfma_f32_16x16x32_bf16(__builtin_bit_cast(bf16x8, w), pf[s2], o, 0, 0, 0); }
                Oacc[dt] = o; }
        }
        __syncthreads();
    }
#undef ATT_LOAD
    lsum += __shfl_xor(lsum, 16); lsum += __shfl_xor(lsum, 32);
    const float inv = 1.f / lsum;
#pragma unroll
    for (int dt = 0; dt < NDT; ++dt) { u32x2 w; w.x = pack2(Oacc[dt][0] * inv, Oacc[dt][1] * inv); w.y = pack2(Oacc[dt][2] * inv, Oacc[dt][3] * inv);
        *(u32x2*)(O + (size_t)qrow * ldo + dt * 16 + 4 * g) = w; }
}

__device__ __forceinline__ void xattn_block(LAS unsigned char* lds, const bf16_t* Q, const bf16_t* Kp, const bf16_t* Vp, bf16_t* O, int q0) {
    constexpr int D = 256, KLD = D + 8, VLD = 72, ldq = 1024, ldk = 8192, ldo = 1024;
    const int tid = otid(), lane = tid & 63, wave = tid >> 6, r = lane & 15, g = lane >> 4;
    LAS bf16_t* Ks = (LAS bf16_t*)lds;
    LAS bf16_t* Vt = Ks + 64 * KLD;
    const int qrow = q0 + 16 * wave + r;
    u32x4 stg[4];
#define XA_LOAD(src, chn) do { _Pragma("unroll") for (int q = 0; q < 4; ++q) { const int pidx = tid + 512 * q; const int key = pidx >> 5, dc = pidx & 31; \
        stg[q] = *(const u32x4*)((src) + (size_t)((chn) * 64 + key) * ldk + dc * 8); } } while (0)
    XA_LOAD(Kp, 0);
    bf16x8 pf[8];
    {
        bf16x8 Qf[8];
#pragma unroll
        for (int ks = 0; ks < 8; ++ks) Qf[ks] = *(const bf16x8*)(Q + (size_t)qrow * ldq + ks * 32 + 8 * g);
        f32x4 s[16];
#pragma unroll
        for (int ch = 0; ch < 4; ++ch) {
#pragma unroll
            for (int q = 0; q < 4; ++q) { const int pidx = tid + 512 * q; const int key = pidx >> 5, dc = pidx & 31; *(LAS u32x4*)(Ks + key * KLD + dc * 8) = stg[q]; }
            __syncthreads();
            if (ch < 3) XA_LOAD(Kp, ch + 1); else XA_LOAD(Vp, 0);
#pragma unroll
            for (int kt = 0; kt < 4; ++kt) { f32x4 a = (f32x4){0.f, 0.f, 0.f, 0.f};
#pragma unroll
                for (int ks = 0; ks < 8; ++ks) { const bf16x8 kf = *(const LAS bf16x8*)(Ks + (kt * 16 + r) * KLD + ks * 32 + 8 * g);
                    a = __builtin_amdgcn_mfma_f32_16x16x32_bf16(kf, Qf[ks], a, 0, 0, 0); }
                s[ch * 4 + kt] = a; }
            __syncthreads();
        }
        float mx = -1e30f;
#pragma unroll
        for (int i = 0; i < 16; ++i) { s[i] = s[i] * 0.0625f; mx = fmaxf(mx, fmaxf(fmaxf(s[i][0], s[i][1]), fmaxf(s[i][2], s[i][3]))); }
        mx = fmaxf(mx, __shfl_xor(mx, 16)); mx = fmaxf(mx, __shfl_xor(mx, 32));
        float ps = 0.f;
#pragma unroll
        for (int i = 0; i < 16; ++i) {
#pragma unroll
            for (int j = 0; j < 4; ++j) { const float pv = __expf(s[i][j] - mx); s[i][j] = pv; ps += pv; } }
        ps += __shfl_xor(ps, 16); ps += __shfl_xor(ps, 32);
        const float inv = 1.f / ps;
#pragma unroll
        for (int k2 = 0; k2 < 8; ++k2) {
            u32x4 w; w.x = pack2(s[2 * k2][0] * inv, s[2 * k2][1] * inv); w.y = pack2(s[2 * k2][2] * inv, s[2 * k2][3] * inv);
            w.z = pack2(s[2 * k2 + 1][0] * inv, s[2 * k2 + 1][1] * inv); w.w = pack2(s[2 * k2 + 1][2] * inv, s[2 * k2 + 1][3] * inv);
            pf[k2] = __builtin_bit_cast(bf16x8, w); }
    }
    f32x4 Oacc[16];
#pragma unroll
    for (int dt = 0; dt < 16; ++dt) Oacc[dt] = (f32x4){0.f, 0.f, 0.f, 0.f};
#pragma unroll
    for (int ch = 0; ch < 4; ++ch) {
#pragma unroll
        for (int q = 0; q < 4; ++q) { const int pidx = tid + 512 * q; const int key = pidx >> 5, dc = pidx & 31; const u32x4 vv = stg[q];
            LAS bf16_t* vd = Vt + (dc * 8) * VLD + (key ^ ((dc & 15) << 2));
            vd[0 * VLD] = (bf16_t)(vv.x & 0xffff); vd[1 * VLD] = (bf16_t)(vv.x >> 16); vd[2 * VLD] = (bf16_t)(vv.y & 0xffff); vd[3 * VLD] = (bf16_t)(vv.y >> 16);
            vd[4 * VLD] = (bf16_t)(vv.z & 0xffff); vd[5 * VLD] = (bf16_t)(vv.z >> 16); vd[6 * VLD] = (bf16_t)(vv.w & 0xffff); vd[7 * VLD] = (bf16_t)(vv.w >> 16); }
        __syncthreads();
        if (ch < 3) XA_LOAD(Vp, ch + 1);
#pragma unroll
        for (int dt = 0; dt < 16; ++dt) { f32x4 o = Oacc[dt];
#pragma unroll
            for (int s2 = 0; s2 < 2; ++s2) { const int sw = ((dt * 2 + (r >> 3)) & 15) << 2; const LAS bf16_t* vrow = Vt + (dt * 16 + r) * VLD;
                const u32x2 lo = *(const LAS u32x2*)(vrow + ((s2 * 32 + 4 * g) ^ sw)), hi = *(const LAS u32x2*)(vrow + ((s2 * 32 + 16 + 4 * g) ^ sw));
                u32x4 w; w.x = lo.x; w.y = lo.y; w.z = hi.x; w.w = hi.y;
                o = __builtin_amdgcn_mfma_f32_16x16x32_bf16(__builtin_bit_cast(bf16x8, w), pf[ch * 2 + s2], o, 0, 0, 0); }
            Oacc[dt] = o; }
        __syncthreads();
    }
#undef XA_LOAD
#pragma unroll
    for (int dt = 0; dt < 16; ++dt) { u32x2 w; w.x = pack2(Oacc[dt][0], Oacc[dt][1]); w.y = pack2(Oacc[dt][2], Oacc[dt][3]);
        *(u32x2*)(O + (size_t)qrow * ldo + dt * 16 + 4 * g) = w; }
}

__device__ __forceinline__ void fox_kmax_tile(const Ctx& c, int l, int tile) {
    const int tid = otid();
    LAS unsigned* sm = (LAS unsigned*)c.lds;
    if (tid < 4) sm[tid] = 0u;
    __syncthreads();
    const size_t tok = (size_t)tile * 64 + (tid >> 3); const int part = tid & 7;
    const bf16_t* kp = c.P() + tok * PLD + C_FK + part * 32;
    float ss = 0.f;
#pragma unroll
    for (int q = 0; q < 4; ++q) { const u32x4 v = *(const u32x4*)(kp + q * 8);
        ss += bflo(v.x) * bflo(v.x) + bfhi(v.x) * bfhi(v.x) + bflo(v.y) * bflo(v.y) + bfhi(v.y) * bfhi(v.y) + bflo(v.z) * bflo(v.z) + bfhi(v.z) * bfhi(v.z) + bflo(v.w) * bflo(v.w) + bfhi(v.w) * bfhi(v.w); }
    ss += dpp_mov<0xB1>(ss);
    if ((part & 1) == 0) __hip_atomic_fetch_max((unsigned*)(sm + (part >> 1)), __float_as_uint(ss), __ATOMIC_RELAXED, __HIP_MEMORY_SCOPE_WORKGROUP);
    __syncthreads();
    if (tid < 4) atomicMax(c.KMAX() + l * 32 + (tile >> 5) * 4 + tid, sm[tid]);
    __syncthreads();
}

__device__ __forceinline__ void fox_block(LAS unsigned char* lds, const bf16_t* Q, const bf16_t* Kp, const bf16_t* Vp, bf16_t* O, int q0, const float* cvec, float kmax2) {
    constexpr int KLD = 72, VLD = 72, ldq = PLD, ldo = 256;
    constexpr int BUFB = (64 * KLD + 64 * VLD) * 2 + 256;
    const int tid = otid(), lane = tid & 63, wave = tid >> 6, r = lane & 15, g = lane >> 4;
    const int qrow = q0 + 16 * wave + r;
    bf16x8 Qf[2];
#pragma unroll
    for (int ks = 0; ks < 2; ++ks) Qf[ks] = *(const bf16x8*)(Q + (size_t)qrow * ldq + ks * 32 + 8 * g);
    float qn = 0.f;
#pragma unroll
    for (int ks = 0; ks < 2; ++ks)
#pragma unroll
        for (int j = 0; j < 8; ++j) { const float e = bf2f((bf16_t)Qf[ks][j]); qn += e * e; }
    qn += __shfl_xor(qn, 16); qn += __shfl_xor(qn, 32);
    constexpr float LOG2E = 1.4426950408889634f;
    const float mq = sqrtf(qn * kmax2) * 0.125f;
    const float cq = cvec[(size_t)qrow * 4];
    const float base2 = (cq - mq) * LOG2E;
    f32x4 Oacc[4];
#pragma unroll
    for (int dt = 0; dt < 4; ++dt) Oacc[dt] = (f32x4){0.f, 0.f, 0.f, 0.f};
    float lsum = 0.f;
    const int nch = (q0 + 128) / 64;
    const int key = tid >> 3, dc = tid & 7;
    u32x4 kreg, vreg; float ckr = 0.f;
#define FX_LOAD(chn) do { const int k0_ = (chn) * 64; kreg = *(const u32x4*)(Kp + (size_t)(k0_ + key) * PLD + dc * 8); vreg = *(const u32x4*)(Vp + (size_t)(k0_ + key) * PLD + dc * 8); \
        if (tid < 64) ckr = cvec[(size_t)(k0_ + tid) * 4]; } while (0)
#define FX_STAGE(chn) do { LAS bf16_t* Ks_ = (LAS bf16_t*)(lds + ((chn) & 1) * BUFB); LAS bf16_t* Vt_ = Ks_ + 64 * KLD; \
        *(LAS u32x4*)(Ks_ + key * KLD + dc * 8) = kreg; \
        LAS bf16_t* vd = Vt_ + (dc * 8) * VLD + (key ^ (dc << 2)); \
        vd[0 * VLD] = (bf16_t)(vreg.x & 0xffff); vd[1 * VLD] = (bf16_t)(vreg.x >> 16); vd[2 * VLD] = (bf16_t)(vreg.y & 0xffff); vd[3 * VLD] = (bf16_t)(vreg.y >> 16); \
        vd[4 * VLD] = (bf16_t)(vreg.z & 0xffff); vd[5 * VLD] = (bf16_t)(vreg.z >> 16); vd[6 * VLD] = (bf16_t)(vreg.w & 0xffff); vd[7 * VLD] = (bf16_t)(vreg.w >> 16); \
        if (tid < 64) ((LAS float*)(Vt_ + 64 * VLD))[tid] = ckr * LOG2E; } while (0)
    FX_LOAD(0); FX_STAGE(0);
    if (nch > 1) FX_LOAD(1);
    __syncthreads();
    for (int ch = 0; ch < nch; ++ch) {
        const int key0 = ch * 64;
        if (ch + 1 < nch) FX_STAGE(ch + 1);
        if (ch + 2 < nch) FX_LOAD(ch + 2);
        if (key0 <= q0 + 16 * wave + 15) {
            const LAS bf16_t* Ks = (const LAS bf16_t*)(lds + (ch & 1) * BUFB); const LAS bf16_t* Vt = Ks + 64 * KLD; const LAS float* ckb = (const LAS float*)(Vt + 64 * VLD);
            f32x4 s[4];
#pragma unroll
            for (int kt = 0; kt < 4; ++kt) { f32x4 a = (f32x4){0.f, 0.f, 0.f, 0.f};
#pragma unroll
                for (int ks = 0; ks < 2; ++ks) { const bf16x8 kf = *(const LAS bf16x8*)(Ks + (kt * 16 + r) * KLD + ks * 32 + 8 * g);
                    a = __builtin_amdgcn_mfma_f32_16x16x32_bf16(kf, Qf[ks], a, 0, 0, 0); }
                s[kt] = a; }
            const bool diag = key0 + 63 > q0 + 16 * wave;
            float ps = 0.f;
#pragma unroll
            for (int kt = 0; kt < 4; ++kt) { const f32x4 ck4 = *(const LAS f32x4*)(ckb + kt * 16 + 4 * g);
#pragma unroll
                for (int reg = 0; reg < 4; ++reg) { float pv = __builtin_amdgcn_exp2f(s[kt][reg] * (0.125f * LOG2E) + (base2 - ck4[reg]));
                    if (diag && key0 + kt * 16 + 4 * g + reg > qrow) pv = 0.f;
                    s[kt][reg] = pv; ps += pv; } }
            lsum += ps;
            bf16x8 pf[2];
#pragma unroll
            for (int s2 = 0; s2 < 2; ++s2) {
                u32x4 w; w.x = pack2(s[2 * s2][0], s[2 * s2][1]); w.y = pack2(s[2 * s2][2], s[2 * s2][3]); w.z = pack2(s[2 * s2 + 1][0], s[2 * s2 + 1][1]); w.w = pack2(s[2 * s2 + 1][2], s[2 * s2 + 1][3]);
                pf[s2] = __builtin_bit_cast(bf16x8, w); }
#pragma unroll
            for (int dt = 0; dt < 4; ++dt) { f32x4 o = Oacc[dt];
#pragma unroll
                for (int s2 = 0; s2 < 2; ++s2) { const int sw = ((dt * 2 + (r >> 3)) & 15) << 2; const LAS bf16_t* vrow = Vt + (dt * 16 + r) * VLD;
                    const u32x2 lo = *(const LAS u32x2*)(vrow + ((s2 * 32 + 4 * g) ^ sw)), hi = *(const LAS u32x2*)(vrow + ((s2 * 32 + 16 + 4 * g) ^ sw));
                    u32x4 w; w.x = lo.x; w.y = lo.y; w.z = hi.x; w.w = hi.y;
                    o = __builtin_amdgcn_mfma_f32_16x16x32_bf16(__builtin_bit_cast(bf16x8, w), pf[s2], o, 0, 0, 0); }
                Oacc[dt] = o; }
        }
        __syncthreads();
    }
#undef FX_LOAD
#undef FX_STAGE
    lsum += __shfl_xor(lsum, 16); lsum += __shfl_xor(lsum, 32);
    const float inv = 1.f / lsum;
#pragma unroll
    for (int dt = 0; dt < 4; ++dt) { u32x2 w; w.x = pack2(Oacc[dt][0] * inv, Oacc[dt][1] * inv); w.y = pack2(Oacc[dt][2] * inv, Oacc[dt][3] * inv);
        *(u32x2*)(O + (size_t)qrow * ldo + dt * 16 + 4 * g) = w; }
}

__device__ __forceinline__ void fox_item(const Ctx& c, int l, int s) {
    const int qt = 15 - (s >> 5), bh = s & 31, b = bh >> 2, h = bh & 3;
    const bf16_t* base = c.P() + (size_t)b * SEQ * PLD;
    const float kmax2 = __uint_as_float(c.KMAX()[l * 32 + bh]);
    fox_block(c.lds, base + C_FQ + h * 64, base + C_FK + h * 64, base + C_FV + h * 64,
              c.Y() + (size_t)3 * NTOK * 256 + (size_t)b * SEQ * 256 + h * 64, qt * 128, c.CF() + (size_t)b * SEQ * 4 + h, kmax2);
}

__device__ __forceinline__ void rw_post(const Ctx& c, int l) {
    const int tid = otid(), lane = tid & 63, wave = tid >> 6;
    const f32x4 lg = *(const f32x4*)(c.in(12) + l * 256 + 4 * lane), lb = *(const f32x4*)(c.in(13) + l * 256 + 4 * lane);
#pragma unroll 4
    for (int tok = c.bid * 8 + wave; tok < NTOK; tok += c.G * 8) {
        const f32x4 y = *(const f32x4*)(c.YRAW() + (size_t)tok * 256 + 4 * lane);
        const float mean = rsum16((y[0] + y[1]) + (y[2] + y[3])) * (1.f / 64.f);
        const f32x4 d = y - mean;
        const float var = rsum16((d[0] * d[0] + d[1] * d[1]) + (d[2] * d[2] + d[3] * d[3])) * (1.f / 64.f);
        const float rstd = rsqrtf(var + 64e-5f);
        f32x4 yn = d * rstd * lg + lb;
        const float bon = c.BON()[(size_t)tok * 4 + (lane >> 4)];
        const u32x2 vv = *(const u32x2*)(c.V() + (size_t)tok * 256 + 4 * lane), gg = *(const u32x2*)(c.Gg() + (size_t)tok * 256 + 4 * lane);
        yn[0] = (yn[0] + bon * bflo(vv.x)) * bflo(gg.x); yn[1] = (yn[1] + bon * bfhi(vv.x)) * bfhi(gg.x);
        yn[2] = (yn[2] + bon * bflo(vv.y)) * bflo(gg.y); yn[3] = (yn[3] + bon * bfhi(vv.y)) * bfhi(gg.y);
        u32x2 w; w.x = pack2(yn[0], yn[1]); w.y = pack2(yn[2], yn[3]);
        *(u32x2*)(c.Y() + (size_t)tok * 256 + 4 * lane) = w;
    }
}

__device__ __forceinline__ void ln_phase(const Ctx& c, int l, int which) {
    const int tid = otid(), lane = tid & 63, wave = tid >> 6;
    const float* gp = c.in(35) + (size_t)(l * 3 + which) * DM; const float* bp = c.in(36) + (size_t)(l * 3 + which) * DM;
    f32x4 gv[4], bv[4];
#pragma unroll
    for (int i = 0; i < 4; ++i) { gv[i] = *(const f32x4*)(gp + i * 256 + 4 * lane); bv[i] = *(const f32x4*)(bp + i * 256 + 4 * lane); }
#pragma unroll 2
    for (int row = c.bid * 8 + wave; row < NTOK; row += c.G * 8) {
        float* xr = c.X + (size_t)row * DM; f32x4 v[4]; float s = 0.f;
#pragma unroll
        for (int i = 0; i < 4; ++i) { v[i] = *(const f32x4*)(xr + i * 256 + 4 * lane); s += (v[i][0] + v[i][1]) + (v[i][2] + v[i][3]); }
        const float mean = wsum64(s) * (1.f / 1024.f); float q = 0.f;
#pragma unroll
        for (int i = 0; i < 4; ++i) { v[i] = v[i] - mean; q += (v[i][0] * v[i][0] + v[i][1] * v[i][1]) + (v[i][2] * v[i][2] + v[i][3] * v[i][3]); }
        const float rstd = rsqrtf(wsum64(q) * (1.f / 1024.f) + LN_EPS);
#pragma unroll
        for (int i = 0; i < 4; ++i) { const f32x4 y = v[i] * rstd * gv[i] + bv[i]; *(f32x4*)(xr + i * 256 + 4 * lane) = y;
            u32x2 w; w.x = pack2(y[0], y[1]); w.y = pack2(y[2], y[3]); *(u32x2*)(c.XB() + (size_t)row * DM + i * 256 + 4 * lane) = w; }
    }
}

#ifndef DUP_GEMM
#define DUP_GEMM 1
#endif
#ifndef DUP_MISC
#define DUP_MISC 1
#endif
__global__ void __launch_bounds__(512, 2) fwd_megakernel(Params p) {
    extern __shared__ __attribute__((aligned(16))) unsigned char lds_raw[];
    cg::grid_group grid = cg::this_grid();
    Ctx c; c.kin = (kin_t)__builtin_amdgcn_kernarg_segment_ptr(); c.ws = p.ws; c.X = p.out; c.lds = (LAS unsigned char*)lds_raw; c.G = gridDim.x; c.bid = blockIdx.x;
    const int G = c.G, bid = c.bid;

#ifndef PH
#define PH 0x3FFFF
#endif
    unsigned* barw = (unsigned*)(p.ws + WS_BAR);
    volatile LAS unsigned* stw = (volatile LAS unsigned*)(c.lds + 131072);
    if (threadIdx.x < 4) stw[threadIdx.x] = 0u;
    if (bid == 0) { for (int i = threadIdx.x; i < XCD_BAR_WORDS; i += 512) barw[i] = 0u; if (threadIdx.x < 128) c.KMAX()[threadIdx.x] = 0u; }
    prepass(c);
    grid.sync();
    const XcdBarrier xbar = xcd_barrier_post(barw, stw);
#define GSYNC() xcd_barrier(xbar)
    {
        pg8::Gemm g{c.Memb(), c.WkvT(), 1024, 1024, 1024}; pg8::StaticOrder S; S.init(2048, 8192, G, bid);
        pg8::EpiStoreBf16 E{c.KV(), 8192};
        if (PH & 0x10000) pg8::gemm_phase(c.lds, g, S, E);
    }
    for (int l = 0; l < DEPTH; ++l) {
        {
            pg8::Gemm g{c.XB(), c.WinT(), 1024, 1024, 1024}; pg8::StaticOrder S; S.init(NTOK, PLD, G, bid);
            pg8::EpiStoreBf16 E{c.P(), PLD};
            for (int d_ = 0; d_ < DUP_GEMM; ++d_) pg8::gemm_phase(c.lds, g, S, E);
        }
        GSYNC();
        for (int d_ = 0; d_ < DUP_MISC; ++d_) {
        if (PH & 4) for (int t = bid; t < 256; t += G) rw_prep_tile(c, l, t);
        if (PH & 8) for (int t = bid; t < 512; t += G) conv_tile(c, l, t);
        if (PH & 16) for (int t = bid; t < NB; t += G) fox_cumsum(c, l, t);
        for (int t = bid; t < 256; t += G) fox_kmax_tile(c, l, t);
        }
        GSYNC();
#ifndef DUP_P2B
#define DUP_P2B 1
#endif
        for (int rep = 0; rep < DUP_P2B; ++rep) {
#ifndef DUP_SCAN
#define DUP_SCAN 1
#endif
#ifndef DUP_GLA
#define DUP_GLA 1
#endif
#ifndef DUP_FOX
#define DUP_FOX 1
#endif
        if (bid < 128) { for (int d_ = 0; d_ < DUP_SCAN; ++d_) rw_scan_item(c, bid); }
        else if (bid < 160) { for (int d_ = 0; d_ < DUP_GLA; ++d_) gla_item(c, l, bid - 128); }
        else for (int d_ = 0; d_ < DUP_FOX; ++d_) { const int j = bid - 160, nbf = G - 160;
            for (int rnd = 0; rnd * nbf < 512; ++rnd) { const int pos = rnd * nbf + ((rnd & 1) ? (nbf - 1 - j) : j); if (pos < 512) fox_item(c, l, pos); } }
        GSYNC();
        }
        for (int d_ = 0; d_ < DUP_MISC; ++d_) rw_post(c, l);
        GSYNC();
        {
            pg8::Gemm g{c.Y(), c.UpT(), 256, 256, 256}; pg8::MergeOrder S; S.so.init(NTOK, 1024, G, bid);
            pg8::EpiMerge E{c.P(), c.in(26) + (size_t)l * 4 * 1024, c.XB()};
            for (int d_ = 0; d_ < DUP_MISC; ++d_) pg8::gemm_phase(c.lds, g, S, E);
        }
        GSYNC();
        {
            pg8::Gemm g{c.XB(), c.WoutT(), 1024, 1024, 1024}; pg8::StaticOrder S; S.init(NTOK, 1024, G, bid);
            pg8::EpiResid E{c.X};
            if (PH & 1024) pg8::gemm_phase(c.lds, g, S, E);
        }
        GSYNC();
        if (PH & 2048) ln_phase(c, l, 0);
        GSYNC();
        {
            pg8::Gemm g{c.XB(), c.WqT(), 1024, 1024, 1024}; pg8::StaticOrder S; S.init(NTOK, 1024, G, bid);
            pg8::EpiStoreBf16 E{c.Qb(), 1024};
            for (int d_ = 0; d_ < DUP_GEMM; ++d_) pg8::gemm_phase(c.lds, g, S, E);
        }
        GSYNC();
        for (int d_ = 0; d_ < DUP_MISC; ++d_) for (int it = bid; it < 512; it += G) { const int qt = it & 15, bh = it >> 4, b = bh >> 2, h = bh & 3;
            const bf16_t* kb = c.KV() + (size_t)b * 256 * 8192 + l * 2048 + h * 256;
            xattn_block(c.lds, c.Qb() + (size_t)b * SEQ * 1024 + h * 256, kb, kb + 1024, c.Ob() + (size_t)b * SEQ * 1024 + h * 256, qt * 128); }
        GSYNC();
        {
            pg8::Gemm g{c.Ob(), c.WoT(), 1024, 1024, 1024}; pg8::StaticOrder S; S.init(NTOK, 1024, G, bid);
            pg8::EpiResid E{c.X};
            if (PH & 1024) pg8::gemm_phase(c.lds, g, S, E);
        }
        GSYNC();
        if (PH & 2048) ln_phase(c, l, 1);
        GSYNC();
        {
            pg8::Gemm g{c.XB(), c.FfuT(), 1024, 1024, 1024}; pg8::StaticOrder S; S.init(NTOK, 2 * DFF, G, bid);
            pg8::EpiSwiglu E{c.Hb()};
            for (int d_ = 0; d_ < DUP_GEMM; ++d_) pg8::gemm_phase(c.lds, g, S, E);
        }
        GSYNC();
        {
            pg8::Gemm g{c.Hb(), c.FfdT(), DFF, DFF, DFF}; pg8::StaticOrder S; S.init(NTOK, 1024, G, bid);
            pg8::EpiResid E{c.X};
            if (PH & 1024) pg8::gemm_phase(c.lds, g, S, E);
        }
        GSYNC();
        if (PH & 2048) ln_phase(c, l, 2);
        if ((PH & 1) && l + 1 < DEPTH) { __syncthreads(); convert_layer(c, l + 1); }
        GSYNC();
    }
}

extern "C" void kernel_launch(void* const* d_in, const int* in_sizes, int n_in, void* d_out, int out_size, void* d_ws, size_t ws_size, hipStream_t stream) {
    static int grid_blocks = 0;
    if (grid_blocks == 0) {
        if (n_in != 37 || out_size != NTOK * DM || ws_size < WS_END) { fprintf(stderr, "kernel_launch: unexpected shapes (n_in %d out %d ws %zu need %zu)\n", n_in, out_size, ws_size, (size_t)WS_END); grid_blocks = -1; return; }
        if (hipFuncSetAttribute((const void*)fwd_megakernel, hipFuncAttributeMaxDynamicSharedMemorySize, LDS_BYTES) != hipSuccess) { fprintf(stderr, "kernel_launch: hipFuncSetAttribute failed\n"); grid_blocks = -1; return; }
        int dev = 0, cus = 0, per_cu = 0;
        (void)hipGetDevice(&dev); (void)hipDeviceGetAttribute(&cus, hipDeviceAttributeMultiprocessorCount, dev);
        (void)hipOccupancyMaxActiveBlocksPerMultiprocessor(&per_cu, (const void*)fwd_megakernel, 512, LDS_BYTES);
        if (per_cu < 1) { fprintf(stderr, "kernel_launch: occupancy query says %d blocks per CU\n", per_cu); per_cu = 1; }
        (void)hipGetLastError();
        grid_blocks = cus;
        if (grid_blocks < 192) { fprintf(stderr, "kernel_launch: too few CUs (%d)\n", cus); grid_blocks = -1; return; }
    }
    if (grid_blocks < 0) return;
    Params p{};
    for (int i = 0; i < 37; ++i) p.in[i] = (const float*)d_in[i];
    p.out = (float*)d_out; p.ws = (unsigned char*)d_ws;
    void* args[] = {&p};
    hipError_t e = hipLaunchCooperativeKernel((const void*)fwd_megakernel, dim3(grid_blocks), dim3(512), args, LDS_BYTES, stream);
    if (e != hipSuccess) fprintf(stderr, "cooperative launch failed: %s (grid %d)\n", hipGetErrorString(e), grid_blocks);
}
```

```cpp
#include <hip/hip_runtime.h>
#include <hip/hip_cooperative_groups.h>
#include <cstdio>
namespace cg = cooperative_groups;

#define LAS __attribute__((address_space(3)))
typedef unsigned short bf16_t;
typedef short bf16x8 __attribute__((ext_vector_type(8)));
typedef float f32x4 __attribute__((ext_vector_type(4)));
typedef unsigned u32x4 __attribute__((ext_vector_type(4)));
typedef unsigned u32x2 __attribute__((ext_vector_type(2)));

constexpr int NTOK = 16384, DM = 1024, SEQ = 2048, NB = 8, DEPTH = 4, DIN = 7220, PLD = 7424, DFF = 2816;
constexpr int C_RWR = 0, C_RWK = 256, C_RWV = 512, C_LORA = 768, C_CVA = 1056, C_CVB = 1312, C_GQ = 1568, C_GK = 1696, C_GV = 1824, C_GR = 2080,
              C_GZ = 2336, C_FQ = 2352, C_FK = 2608, C_FV = 2864, C_FZ = 3120, C_GATE = 3328;
constexpr float ALPHA = 1.681792830507429f;
constexpr float LN_EPS = 1e-5f;

constexpr size_t WS_WIN = 0;
constexpr size_t WS_UP = WS_WIN + (size_t)PLD * 1024 * 2;
constexpr size_t WS_WOUT = WS_UP + (size_t)4 * 1024 * 256 * 2;
constexpr size_t WS_WQ = WS_WOUT + (size_t)1024 * 1024 * 2;
constexpr size_t WS_WO = WS_WQ + (size_t)1024 * 1024 * 2;
constexpr size_t WS_FFU = WS_WO + (size_t)1024 * 1024 * 2;
constexpr size_t WS_FFD = WS_FFU + (size_t)5632 * 1024 * 2;
constexpr size_t WS_KV = WS_FFD + (size_t)1024 * DFF * 2;
constexpr size_t WS_XB = WS_KV + (size_t)2048 * 8192 * 2;
constexpr size_t WS_Y = WS_XB + (size_t)NTOK * 1024 * 2;
constexpr size_t WS_DEC = WS_Y + (size_t)4 * NTOK * 256 * 2;
constexpr size_t WS_R = WS_DEC + (size_t)NTOK * 256 * 4;
constexpr size_t WS_KM = WS_R + (size_t)NTOK * 256 * 2;
constexpr size_t WS_V = WS_KM + (size_t)NTOK * 256 * 2;
constexpr size_t WS_AN = WS_V + (size_t)NTOK * 256 * 2;
constexpr size_t WS_BN = WS_AN + (size_t)NTOK * 256 * 2;
constexpr size_t WS_CF = WS_BN + (size_t)NTOK * 256 * 2;
constexpr size_t WS_P = WS_CF + (size_t)NTOK * 4 * 4;
constexpr size_t WS_LORA = WS_P + (size_t)NTOK * PLD * 2;
constexpr size_t WS_BAR = WS_LORA + (size_t)256 * 288 * 2;
constexpr size_t WS_KMAX = WS_BAR + 16384;
constexpr size_t WS_END = WS_KMAX + 1024;
constexpr size_t XB_YRAW = 0, XB_G = (size_t)NTOK * 256 * 4, XB_BON = XB_G + (size_t)NTOK * 256 * 2;
constexpr size_t Y_MEMB = 0, Y_WKV = (size_t)2048 * 1024 * 2;
constexpr size_t P_Q = 0, P_O = (size_t)NTOK * 1024 * 2, P_H = (size_t)2 * NTOK * 1024 * 2;

constexpr int LDS_BYTES = 131072 + 16;

struct Params { const float* in[37]; float* out; unsigned char* ws; };

__device__ __forceinline__ float bf2f(bf16_t b) { return __uint_as_float(((unsigned)b) << 16); }
__device__ __forceinline__ float bflo(unsigned w) { return __uint_as_float(w << 16); }
__device__ __forceinline__ float bfhi(unsigned w) { return __uint_as_float(w & 0xffff0000u); }
__device__ __forceinline__ bf16_t f2bf(float f) { unsigned u = __float_as_uint(f); u += 0x7FFFu + ((u >> 16) & 1u); return (bf16_t)(u >> 16); }
__device__ __forceinline__ unsigned pack2(float lo, float hi) { return (unsigned)f2bf(lo) | ((unsigned)f2bf(hi) << 16); }
__device__ __forceinline__ float sigmoidf_(float x) { return 1.0f / (1.0f + __expf(-x)); }
__device__ __forceinline__ float siluf_(float x) { return x / (1.0f + __expf(-x)); }
__device__ __forceinline__ float logsigf_(float x) { return fminf(x, 0.f) - log1pf(__expf(-fabsf(x))); }
__device__ __forceinline__ float wsum64(float v) { v += __shfl_xor(v, 32); v += __shfl_xor(v, 16); v += __shfl_xor(v, 8); v += __shfl_xor(v, 4); v += __shfl_xor(v, 2); v += __shfl_xor(v, 1); return v; }
__device__ __forceinline__ float rsum16(float v) { v += __shfl_xor(v, 8); v += __shfl_xor(v, 4); v += __shfl_xor(v, 2); v += __shfl_xor(v, 1); return v; }

typedef float f32x2 __attribute__((ext_vector_type(2)));
template <int CTRL> __device__ __forceinline__ float dpp_mov(float x) { return __int_as_float(__builtin_amdgcn_update_dpp(0, __float_as_int(x), CTRL, 0xF, 0xF, true)); }
__device__ __forceinline__ float dsum16(float x) { x += dpp_mov<0xB1>(x); x += dpp_mov<0x4E>(x); x += dpp_mov<0x124>(x); x += dpp_mov<0x128>(x); return x; }
__device__ __forceinline__ float dsum8(float x) { x += dpp_mov<0xB1>(x); x += dpp_mov<0x4E>(x); x += dpp_mov<0x141>(x); return x; }
__device__ __forceinline__ int otid() { int t = threadIdx.x; asm volatile("" : "+v"(t)); return t; }


#define XB_TMO      128
#define XB_XCNT(j)  (256  + 64 * (j))
#define XB_XSUB(j)  (1280 + 64 * (j))
#define XB_XGEN(j)  (2304 + 64 * (j))
#define XB_TOP      3328
#define XB_TOPGEN   3392
#define XCD_BAR_WORDS 3456
#define XB_SPIN_CAP (1u << 18)
__device__ __forceinline__ unsigned xb_ld(unsigned* p)              { return __hip_atomic_load(p, __ATOMIC_RELAXED, __HIP_MEMORY_SCOPE_AGENT); }
__device__ __forceinline__ unsigned xb_add(unsigned* p, unsigned v) { return __hip_atomic_fetch_add(p, v, __ATOMIC_RELAXED, __HIP_MEMORY_SCOPE_AGENT); }
__device__ __forceinline__ unsigned xb_xcc_id() { return (unsigned)__builtin_amdgcn_s_getreg((3 << 11) | 20) & 0xFu; }
#define XB_SPIN(cond, bar) do { unsigned _sp = 0; while (cond) { __builtin_amdgcn_s_sleep(1); \
    if ((++_sp & 255u) == 0u) { if (xb_ld(&(bar)[XB_TMO])) break; if (_sp > XB_SPIN_CAP) { atomicAdd(&(bar)[XB_TMO], 1u); break; } } } } while (0)
struct XcdBarrier { unsigned* bar; unsigned x; volatile LAS unsigned* st; };
__device__ __forceinline__ XcdBarrier xcd_barrier_post(unsigned* bar, volatile LAS unsigned* st) {
    XcdBarrier b; b.bar = bar; b.x = xb_xcc_id(); b.st = st;
    if (threadIdx.x == 0) (void)xb_add(&bar[XB_XCNT(b.x)], 1u);
    return b;
}
__device__ __forceinline__ void xcd_barrier_complete(unsigned* bar, unsigned x, unsigned& nloc, unsigned& nx) {
    const unsigned G = gridDim.x * gridDim.y * gridDim.z;
    unsigned sum, cnt, mine, sp = 0u;
    for (;;) {
        sum = 0u; cnt = 0u; mine = 0u;
#pragma unroll
        for (unsigned j = 0; j < 16; ++j) { const unsigned c = xb_ld(&bar[XB_XCNT(j)]); sum += c; cnt += (c > 0u) ? 1u : 0u; mine = (j == x) ? c : mine; }
        if (sum == G) break;
        __builtin_amdgcn_s_sleep(1);
        if ((++sp & 255u) == 0u) { if (xb_ld(&bar[XB_TMO])) break; if (sp > XB_SPIN_CAP) { atomicAdd(&bar[XB_TMO], 1u); break; } }
    }
    nloc = mine > 0u ? mine : 1u; nx = cnt > 0u ? cnt : 1u;
}
__device__ __forceinline__ void xcd_barrier(const XcdBarrier& b) {
    asm volatile("s_waitcnt vmcnt(0)" ::: "memory");
    __syncthreads();
    if (threadIdx.x == 0) {
        unsigned* bar = b.bar;
        __builtin_amdgcn_s_waitcnt(0);
        unsigned nloc = b.st[0], nx = b.st[1];
        if (nloc == 0u) { xcd_barrier_complete(bar, b.x, nloc, nx); b.st[0] = nloc; b.st[1] = nx; }
        const unsigned old = xb_add(&bar[XB_XSUB(b.x)], 1u);
        const unsigned gen = old / nloc;
        if (old + 1u == (gen + 1u) * nloc) {
            __builtin_amdgcn_fence(__ATOMIC_RELEASE, "agent");
            asm volatile("s_waitcnt vmcnt(0)" ::: "memory");
            const unsigned og = xb_add(&bar[XB_TOP], 1u);
            const unsigned tg = og / nx;
            if (og + 1u == (tg + 1u) * nx) xb_add(&bar[XB_TOPGEN], 1u);
            else XB_SPIN(xb_ld(&bar[XB_TOPGEN]) == tg, bar);
            __builtin_amdgcn_fence(__ATOMIC_ACQUIRE, "agent");
            xb_add(&bar[XB_XGEN(b.x)], 1u);
            asm volatile("s_waitcnt vmcnt(0)" ::: "memory");
        } else {
            XB_SPIN(xb_ld(&bar[XB_XGEN(b.x)]) == gen, bar);
            __builtin_amdgcn_fence(__ATOMIC_ACQUIRE, "agent");
            asm volatile("s_waitcnt vmcnt(0)" ::: "memory");
        }
    }
    __syncthreads();
}

namespace pg8 {
constexpr int BM = 256, BK = 64, HALF = 128, HTB = HALF * BK * 2, NXCD = 8, WGM = 8;
__device__ __forceinline__ int lds_byte(int r, int c) { const int st = (r >> 4) * 2 + (c >> 5), rr = r & 15, cc = c & 31, ob = rr * 64 + cc * 2; return st * 1024 + (ob ^ (((ob >> 9) & 1) << 5)); }
__device__ __forceinline__ void stage_rc(int b, int& R, int& C) { const int st = b / 1024, sb = b % 1024, swz = sb ^ (((sb >> 9) & 1) << 5); R = (st >> 1) * 16 + swz / 64; C = (st & 1) * 32 + (swz % 64) / 2; }
__device__ __forceinline__ int perm32(int rho) { const int n = rho >> 4, i = rho & 15; return 8 * (i >> 2) + 4 * n + (i & 3); }
struct Unit { int pm, pn; };
struct Gemm { const bf16_t* A; const bf16_t* Bt; int lda, ldb, K; };
struct StaticOrder {
    int nM, nN, nwg, G, c;
    __device__ __forceinline__ void init(int M, int N, int G_, int c_) { nM = M / BM; nN = N / BM; nwg = nM * nN; G = G_; c = c_; }
    __device__ __forceinline__ bool next(int i, Unit& u) const {
        const long L = (long)i * G + c; if (L >= nwg) return false;
        int wgid = (int)L; { const int q = nwg / NXCD, r = nwg % NXCD, xcd = wgid % NXCD, off = wgid / NXCD; wgid = (xcd < r ? xcd * (q + 1) : r * (q + 1) + (xcd - r) * q) + off; }
        const int nig = WGM * nN, gid = wgid / nig, fm = gid * WGM, gsz = WGM;
        u.pm = fm + ((wgid % nig) % gsz); u.pn = (wgid % nig) / gsz; return true;
    }
};
struct MergeOrder {
    StaticOrder so;
    __device__ __forceinline__ bool next(int i, Unit& u) const { Unit t; if (!so.next(i >> 2, t)) return false; const int br = i & 3; u.pm = br * 64 + t.pm; u.pn = br * 4 + t.pn; return true; }
};
__device__ __forceinline__ unsigned cvt_pk_bf16(float lo, float hi) { unsigned r; asm volatile("v_cvt_pk_bf16_f32 %0, %1, %2" : "=v"(r) : "v"(lo), "v"(hi)); return r; }

struct EpiStoreBf16 {
    static constexpr bool PERM = true;
    bf16_t* O; int ldc;
    __device__ __forceinline__ void operator()(const f32x4 (&acc)[2][2][4][2], const Unit& u, int wr, int wc, int fr, int fq) const {
        const int row0 = u.pm * BM + wr * 64 + fr, col0 = u.pn * BM + wc * 32 + 8 * fq;
#pragma unroll
        for (int ai = 0; ai < 2; ++ai)
#pragma unroll
            for (int m = 0; m < 4; ++m) { bf16_t* rowp = O + (size_t)(row0 + ai * HALF + m * 16) * ldc + col0;
#pragma unroll
                for (int bj = 0; bj < 2; ++bj) { const f32x4 v0 = acc[ai][bj][m][0], v1 = acc[ai][bj][m][1];
                    u32x4 w; w.x = cvt_pk_bf16(v0[0], v0[1]); w.y = cvt_pk_bf16(v0[2], v0[3]); w.z = cvt_pk_bf16(v1[0], v1[1]); w.w = cvt_pk_bf16(v1[2], v1[3]);
                    *(u32x4*)(rowp + bj * HALF) = w; } }
    }
};
struct EpiResid {
    static constexpr bool PERM = false;
    float* X;
    __device__ __forceinline__ void operator()(const f32x4 (&acc)[2][2][4][2], const Unit& u, int wr, int wc, int fr, int fq) const {
        const int row0 = u.pm * BM + wr * 64 + fr, col0 = u.pn * BM + wc * 32 + 4 * fq;
#pragma unroll
        for (int ai = 0; ai < 2; ++ai) {
            f32x4 xv[4][2][2];
#pragma unroll
            for (int m = 0; m < 4; ++m) { const float* rowp = X + (size_t)(row0 + ai * HALF + m * 16) * DM + col0;
#pragma unroll
                for (int bj = 0; bj < 2; ++bj)
#pragma unroll
                    for (int n = 0; n < 2; ++n) xv[m][bj][n] = *(const f32x4*)(rowp + bj * HALF + n * 16); }
#pragma unroll
            for (int m = 0; m < 4; ++m) { float* rowp = X + (size_t)(row0 + ai * HALF + m * 16) * DM + col0;
#pragma unroll
                for (int bj = 0; bj < 2; ++bj)
#pragma unroll
                    for (int n = 0; n < 2; ++n) *(f32x4*)(rowp + bj * HALF + n * 16) = xv[m][bj][n] * ALPHA + acc[ai][bj][m][n]; }
            asm volatile("" ::: "memory");
        }
    }
};
struct EpiSwiglu {
    static constexpr bool PERM = true;
    bf16_t* H;
    __device__ __forceinline__ void operator()(const f32x4 (&acc)[2][2][4][2], const Unit& u, int wr, int wc, int fr, int fq) const {
        const int row0 = u.pm * BM + wr * 64 + fr, col0 = u.pn * HALF + wc * 32 + 8 * fq;
#pragma unroll
        for (int ai = 0; ai < 2; ++ai)
#pragma unroll
            for (int m = 0; m < 4; ++m) { bf16_t* rowp = H + (size_t)(row0 + ai * HALF + m * 16) * DFF + col0;
                float h[8];
#pragma unroll
                for (int n = 0; n < 2; ++n)
#pragma unroll
                    for (int j = 0; j < 4; ++j) { const float a = acc[ai][0][m][n][j], b = acc[ai][1][m][n][j]; h[n * 4 + j] = siluf_(a) * b; }
                u32x4 w; w.x = cvt_pk_bf16(h[0], h[1]); w.y = cvt_pk_bf16(h[2], h[3]); w.z = cvt_pk_bf16(h[4], h[5]); w.w = cvt_pk_bf16(h[6], h[7]);
                *(u32x4*)rowp = w; }
    }
};
struct EpiMerge {
    static constexpr bool PERM = true;
    const bf16_t* P; const float* gate_b; bf16_t* Mg;
    __device__ __forceinline__ void operator()(const f32x4 (&acc)[2][2][4][2], const Unit& u, int wr, int wc, int fr, int fq) const {
        const int br = u.pm >> 6, pm = u.pm & 63, pn = u.pn & 3;
        const int row0 = pm * BM + wr * 64 + fr, col0 = pn * BM + wc * 32 + 8 * fq;
#pragma unroll
        for (int bj = 0; bj < 2; ++bj) { const int col = col0 + bj * HALF;
            const f32x4 gb0 = *(const f32x4*)(gate_b + br * 1024 + col), gb1 = *(const f32x4*)(gate_b + br * 1024 + col + 4);
#pragma unroll
            for (int ai = 0; ai < 2; ++ai) {
                u32x4 gw[4], ov[4];
#pragma unroll
                for (int m = 0; m < 4; ++m) { const size_t row = (size_t)(row0 + ai * HALF + m * 16);
                    gw[m] = *(const u32x4*)(P + row * PLD + C_GATE + br * 1024 + col);
                    ov[m] = (u32x4){0u, 0u, 0u, 0u}; if (br > 0) ov[m] = *(const u32x4*)(Mg + row * DM + col); }
#pragma unroll
                for (int m = 0; m < 4; ++m) { const size_t row = (size_t)(row0 + ai * HALF + m * 16); const u32x4 g4 = gw[m], o = ov[m];
                    float v[8];
                    v[0] = sigmoidf_(bflo(g4.x) + gb0[0]) * acc[ai][bj][m][0][0] + bflo(o.x); v[1] = sigmoidf_(bfhi(g4.x) + gb0[1]) * acc[ai][bj][m][0][1] + bfhi(o.x);
                    v[2] = sigmoidf_(bflo(g4.y) + gb0[2]) * acc[ai][bj][m][0][2] + bflo(o.y); v[3] = sigmoidf_(bfhi(g4.y) + gb0[3]) * acc[ai][bj][m][0][3] + bfhi(o.y);
                    v[4] = sigmoidf_(bflo(g4.z) + gb1[0]) * acc[ai][bj][m][1][0] + bflo(o.z); v[5] = sigmoidf_(bfhi(g4.z) + gb1[1]) * acc[ai][bj][m][1][1] + bfhi(o.z);
                    v[6] = sigmoidf_(bflo(g4.w) + gb1[2]) * acc[ai][bj][m][1][2] + bflo(o.w); v[7] = sigmoidf_(bfhi(g4.w) + gb1[3]) * acc[ai][bj][m][1][3] + bfhi(o.w);
                    u32x4 w; w.x = cvt_pk_bf16(v[0], v[1]); w.y = cvt_pk_bf16(v[2], v[3]); w.z = cvt_pk_bf16(v[4], v[5]); w.w = cvt_pk_bf16(v[6], v[7]);
                    *(u32x4*)(Mg + row * DM + col) = w; }
                asm volatile("" ::: "memory"); }
            asm volatile("" ::: "memory"); }
    }
};

template <class Epi, class Sched>
__device__ __forceinline__ void gemm_phase(LAS unsigned char* lds, const Gemm g, const Sched& S, const Epi& E) {
    const int tid = otid(), wid = __builtin_amdgcn_readfirstlane(tid >> 6), lane = tid & 63, wr = wid >> 2, wc = wid & 3, fr = lane & 15, fq = lane >> 4;
    const int K = g.K, nt = K / BK;
    unsigned voffA[2], voffB[2];
#pragma unroll
    for (int i = 0; i < 2; ++i) { int R, C; stage_rc(tid * 16 + i * 8192, R, C); const int Rb = Epi::PERM ? ((R & ~31) + perm32(R & 31)) : R;
        voffA[i] = (unsigned)(R * g.lda + C) * 2u; voffB[i] = (unsigned)(Rb * g.ldb + C) * 2u; }
    const size_t kstep = (size_t)(BK * 2);
    const size_t hstepA = (size_t)HALF * g.lda * 2, hstepB = (size_t)HALF * g.ldb * 2;
    const size_t tstepA = 2 * hstepA, tstepB = 2 * hstepB;
    const unsigned ldsw = (unsigned)wid * 1024u;
    const int aoff = lds_byte(wr * 64 + fr, fq * 8), boff = lds_byte(wc * 32 + fr, fq * 8);
#define PG8_SA(b, h) (((b) * 2 + (h)) * HTB)
#define PG8_SB(b, h) ((4 + (b) * 2 + (h)) * HTB)
#define PG8_STAGE(bufoff, gbase, voff) do { _Pragma("unroll") for (int _i = 0; _i < 2; ++_i) \
        __builtin_amdgcn_global_load_lds((const unsigned*)((const char*)(gbase) + (voff)[_i]), (LAS unsigned*)(lds + (bufoff) + ldsw + _i * 8192), 16, 0, 0); } while (0)
#define PG8_LDA(dst, b, h) do { _Pragma("unroll") for (int m = 0; m < 4; ++m) _Pragma("unroll") for (int k = 0; k < 2; ++k) dst[m][k] = *(const LAS bf16x8*)(lds + PG8_SA(b, h) + aoff + m * 2048 + k * 1024); } while (0)
#define PG8_LDB(dst, b, h) do { _Pragma("unroll") for (int n = 0; n < 2; ++n) _Pragma("unroll") for (int k = 0; k < 2; ++k) dst[n][k] = *(const LAS bf16x8*)(lds + PG8_SB(b, h) + boff + n * 2048 + k * 1024); } while (0)
#define PG8_MMA(ai, bj, At, Bt) do { __builtin_amdgcn_s_setprio(1); _Pragma("unroll") for (int m = 0; m < 4; ++m) _Pragma("unroll") for (int n = 0; n < 2; ++n) _Pragma("unroll") for (int k = 0; k < 2; ++k) \
        acc[ai][bj][m][n] = __builtin_amdgcn_mfma_f32_16x16x32_bf16(Bt[n][k], At[m][k], acc[ai][bj][m][n], 0, 0, 0); __builtin_amdgcn_s_setprio(0); } while (0)
#define PG8_WAIT_V(n) asm volatile("s_waitcnt vmcnt(" #n ")" ::: "memory")
#define PG8_WAIT_L(n) asm volatile("s_waitcnt lgkmcnt(" #n ")" ::: "memory")
#define PG8_BAR __builtin_amdgcn_s_barrier()
#define PG8_SCHED __builtin_amdgcn_sched_barrier(0)
    Unit cur, nxt; int ui = 0;
    if (!S.next(0, cur)) return;
    f32x4 acc[2][2][4][2];
#pragma unroll
    for (int a = 0; a < 2; ++a)
#pragma unroll
        for (int b = 0; b < 2; ++b)
#pragma unroll
            for (int m = 0; m < 4; ++m)
#pragma unroll
                for (int n = 0; n < 2; ++n) acc[a][b][m][n] = (f32x4){0.f, 0.f, 0.f, 0.f};
    bf16x8 At[4][2], B0[2][2], B1[2][2];
    const char* cA = (const char*)g.A + (size_t)cur.pm * tstepA; const char* cB = (const char*)g.Bt + (size_t)cur.pn * tstepB;
    PG8_STAGE(PG8_SB(0, 0), cB, voffB); PG8_STAGE(PG8_SA(0, 0), cA, voffA); PG8_STAGE(PG8_SB(0, 1), cB + hstepB, voffB); PG8_STAGE(PG8_SA(0, 1), cA + hstepA, voffA);
    if (wr == 1) PG8_BAR;
    PG8_WAIT_V(4); PG8_BAR;
    PG8_STAGE(PG8_SB(1, 0), cB + kstep, voffB); PG8_STAGE(PG8_SA(1, 0), cA + kstep, voffA); PG8_STAGE(PG8_SB(1, 1), cB + hstepB + kstep, voffB);
    PG8_WAIT_V(6); PG8_BAR;
    for (;;) {
        const bool has_next = S.next(ui + 1, nxt);
        const char* nA = has_next ? (const char*)g.A + (size_t)nxt.pm * tstepA : cA; const char* nB = has_next ? (const char*)g.Bt + (size_t)nxt.pn * tstepB : cB;
#pragma unroll 1
        for (int t = 0; t < nt; t += 2) {
            const bool last = (t == nt - 2);
            const char* a1 = cA + (size_t)(t + 1) * kstep;
            const char* a2 = last ? nA : cA + (size_t)(t + 2) * kstep; const char* b2 = last ? nB : cB + (size_t)(t + 2) * kstep;
            const char* a3 = a2 + kstep; const char* b3 = b2 + kstep;
            PG8_LDB(B0, 0, 0); PG8_SCHED; PG8_LDA(At, 0, 0); PG8_STAGE(PG8_SA(1, 1), a1 + hstepA, voffA);
            PG8_WAIT_L(8); PG8_BAR; PG8_WAIT_L(0); PG8_MMA(0, 0, At, B0); PG8_BAR; PG8_SCHED;
            PG8_LDB(B1, 0, 1); PG8_STAGE(PG8_SB(0, 0), b2, voffB);
            PG8_BAR; PG8_WAIT_L(0); PG8_MMA(0, 1, At, B1); PG8_BAR;
            PG8_LDA(At, 0, 1); PG8_STAGE(PG8_SA(0, 0), a2, voffA);
            PG8_BAR; PG8_WAIT_L(0); PG8_MMA(1, 0, At, B0); PG8_BAR; PG8_SCHED;
            PG8_STAGE(PG8_SB(0, 1), b2 + hstepB, voffB);
            PG8_WAIT_V(6); PG8_BAR; PG8_MMA(1, 1, At, B1); PG8_BAR;
            PG8_LDB(B0, 1, 0); PG8_SCHED; PG8_LDA(At, 1, 0); PG8_STAGE(PG8_SA(0, 1), a2 + hstepA, voffA);
            PG8_WAIT_L(8); PG8_BAR; PG8_WAIT_L(0); PG8_MMA(0, 0, At, B0); PG8_BAR; PG8_SCHED;
            PG8_LDB(B1, 1, 1); PG8_STAGE(PG8_SB(1, 0), b3, voffB);
            PG8_BAR; PG8_WAIT_L(0); PG8_MMA(0, 1, At, B1); PG8_BAR;
            PG8_LDA(At, 1, 1); PG8_STAGE(PG8_SA(1, 0), a3, voffA);
            PG8_BAR; PG8_WAIT_L(0); PG8_MMA(1, 0, At, B0); PG8_BAR; PG8_SCHED;
            PG8_STAGE(PG8_SB(1, 1), b3 + hstepB, voffB);
            PG8_WAIT_V(6); PG8_BAR; PG8_MMA(1, 1, At, B1); PG8_BAR;
        }
        E(acc, cur, wr, wc, fr, fq);
        if (!has_next) break;
#pragma unroll
        for (int a = 0; a < 2; ++a)
#pragma unroll
            for (int b = 0; b < 2; ++b)
#pragma unroll
                for (int m = 0; m < 4; ++m)
#pragma unroll
                    for (int n = 0; n < 2; ++n) acc[a][b][m][n] = (f32x4){0.f, 0.f, 0.f, 0.f};
        cur = nxt; cA = nA; cB = nB; ++ui;
    }
    PG8_WAIT_V(0);
    if (wr == 0) PG8_BAR;
    PG8_BAR;
#undef PG8_SA
#undef PG8_SB
#undef PG8_STAGE
#undef PG8_LDA
#undef PG8_LDB
#undef PG8_MMA
#undef PG8_WAIT_V
#undef PG8_WAIT_L
#undef PG8_BAR
#undef PG8_SCHED
}
}

__device__ __forceinline__ void tconv_tile(LAS float* tile, const float* src, int ldS, int sc0, int scLimit, bf16_t* dst, int ldD, int dr0, int k0) {
    const int tid = otid();
    { const int r = tid >> 4, c4 = (tid & 15) * 4;
#pragma unroll
      for (int h = 0; h < 2; ++h) { const int k = r + 32 * h; f32x4 v = (f32x4){0.f, 0.f, 0.f, 0.f};
          if (sc0 + c4 < scLimit) v = *(const f32x4*)(src + (size_t)(k0 + k) * ldS + sc0 + c4);
          tile[k * 65 + c4 + 0] = v[0]; tile[k * 65 + c4 + 1] = v[1]; tile[k * 65 + c4 + 2] = v[2]; tile[k * 65 + c4 + 3] = v[3]; } }
    __syncthreads();
    { const int n = tid >> 3, kc = (tid & 7) * 8; float e[8];
#pragma unroll
      for (int i = 0; i < 8; ++i) e[i] = tile[(kc + i) * 65 + n];
      u32x4 w; w.x = pack2(e[0], e[1]); w.y = pack2(e[2], e[3]); w.z = pack2(e[4], e[5]); w.w = pack2(e[6], e[7]);
      *(u32x4*)(dst + (size_t)(dr0 + n) * ldD + k0 + kc) = w; }
    __syncthreads();
}

typedef const float* const __attribute__((address_space(4)))* kin_t;
struct Ctx {
    kin_t kin; unsigned char* ws; float* X; LAS unsigned char* lds; int G, bid;
    __device__ __forceinline__ const float* in(int k) const { int z = k; asm volatile("" : "+s"(z)); return kin[z]; }
#define WSP(name, T, off) __device__ __forceinline__ T* name() const { return (T*)(ws + (off)); }
    WSP(WinT, bf16_t, WS_WIN) WSP(UpT, bf16_t, WS_UP) WSP(WoutT, bf16_t, WS_WOUT) WSP(WqT, bf16_t, WS_WQ) WSP(WoT, bf16_t, WS_WO)
    WSP(FfuT, bf16_t, WS_FFU) WSP(FfdT, bf16_t, WS_FFD) WSP(KV, bf16_t, WS_KV) WSP(XB, bf16_t, WS_XB) WSP(Y, bf16_t, WS_Y)
    WSP(R, bf16_t, WS_R) WSP(KM, bf16_t, WS_KM) WSP(V, bf16_t, WS_V) WSP(AN, bf16_t, WS_AN) WSP(BN, bf16_t, WS_BN)
    WSP(P, bf16_t, WS_P) WSP(Gg, bf16_t, WS_XB + XB_G) WSP(Qb, bf16_t, WS_P + P_Q) WSP(Ob, bf16_t, WS_P + P_O) WSP(Hb, bf16_t, WS_P + P_H)
    WSP(Memb, bf16_t, WS_Y + Y_MEMB) WSP(WkvT, bf16_t, WS_Y + Y_WKV)
    WSP(LoraT, bf16_t, WS_LORA) WSP(KMAX, unsigned, WS_KMAX)
    WSP(DEC, float, WS_DEC) WSP(CF, float, WS_CF) WSP(YRAW, float, WS_XB + XB_YRAW) WSP(BON, float, WS_XB + XB_BON)
#undef WSP
};

__device__ __forceinline__ void convert_layer(const Ctx& c, int l) {
    LAS float* tile = (LAS float*)c.lds;
    { const float* w2 = c.in(5) + (size_t)l * 64 * 256; const float* a2 = c.in(7) + (size_t)l * 64 * 256; const float* g2 = c.in(8) + (size_t)l * 160 * 256; bf16_t* LT = c.LoraT();
      for (int i = c.bid * 512 + otid(); i < 288 * 256; i += c.G * 512) { const int k = i >> 8, n = i & 255;
          const float v = k < 64 ? w2[k * 256 + n] : (k < 128 ? a2[(k - 64) * 256 + n] : g2[(k - 128) * 256 + n]); LT[n * 288 + k] = f2bf(v); } }
    for (int t = c.bid; t < 4992; t += c.G) {
        if (t < 1856) { const int nt = t % 116, kt = t / 116; const int n0 = nt * 64;
            const float* src = c.in(2) + (size_t)l * 1024 * DIN;
            if (n0 < C_GATE) tconv_tile(tile, src, DIN, n0, 3124, c.WinT(), 1024, n0, kt * 64);
            else tconv_tile(tile, src, DIN, n0 - 204, DIN, c.WinT(), 1024, n0, kt * 64);
        } else if (t < 2112) { const int q = t - 1856, br = q >> 6, r = q & 63, nt = r & 15, kt = r >> 4;
            const float* srcu = br == 0 ? c.in(14) : (br == 1 ? c.in(19) : (br == 2 ? c.in(23) : c.in(25)));
            tconv_tile(tile, srcu + (size_t)l * 256 * 1024, 1024, nt * 64, 1024, c.UpT() + (size_t)br * 1024 * 256, 256, nt * 64, kt * 64);
        } else if (t < 2880) { const int q = t - 2112, w = q >> 8, r = q & 255, nt = r & 15, kt = r >> 4;
            const float* srcw = w == 0 ? c.in(27) : (w == 1 ? c.in(28) : c.in(31)); bf16_t* dst = w == 0 ? c.WoutT() : (w == 1 ? c.WqT() : c.WoT());
            tconv_tile(tile, srcw + (size_t)l * 1024 * 1024, 1024, nt * 64, 1024, dst, 1024, nt * 64, kt * 64);
        } else if (t < 4288) { const int q = t - 2880, nt = q % 88, kt = q / 88; const int n0 = nt * 64, u = n0 >> 8, r = n0 & 255;
            const float* src = (r < 128 ? c.in(32) : c.in(33)) + (size_t)l * 1024 * DFF;
            tconv_tile(tile, src, DFF, u * 128 + (r & 127), DFF, c.FfuT(), 1024, n0, kt * 64);
        } else { const int q = t - 4288, nt = q & 15, kt = q >> 4;
            tconv_tile(tile, c.in(34) + (size_t)l * DFF * 1024, 1024, nt * 64, 1024, c.FfdT(), DFF, nt * 64, kt * 64);
        }
    }
}

__device__ __forceinline__ void prepass(const Ctx& c) {
    const int gtid = c.bid * 512 + otid(), gsz = c.G * 512;
    { const f32x4* xs = (const f32x4*)c.in(0); f32x4* xd = (f32x4*)c.X; u32x2* xb = (u32x2*)c.XB();
      for (int i = gtid; i < NTOK * DM / 4; i += gsz) { const f32x4 v = xs[i]; xd[i] = v; u32x2 w; w.x = pack2(v[0], v[1]); w.y = pack2(v[2], v[3]); xb[i] = w; } }
    { const f32x4* ms = (const f32x4*)c.in(1); u32x2* mb = (u32x2*)c.Memb();
      for (int i = gtid; i < 2048 * DM / 4; i += gsz) { const f32x4 v = ms[i]; u32x2 w; w.x = pack2(v[0], v[1]); w.y = pack2(v[2], v[3]); mb[i] = w; } }
    LAS float* tile = (LAS float*)c.lds;
    for (int t = c.bid; t < 2048; t += c.G) {
        const int lw = t >> 8, r = t & 255, nt = r & 15, kt = r >> 4; const int l = lw >> 1, which = lw & 1;
        tconv_tile(tile, (which ? c.in(30) : c.in(29)) + (size_t)l * 1024 * 1024, 1024, nt * 64, 1024, c.WkvT(), 1024, lw * 1024 + nt * 64, kt * 64);
    }
    convert_layer(c, 0);
}

__device__ __forceinline__ void rw_prep_tile(const Ctx& c, int l, int tile) {
    const int tid = otid(), lane = tid & 63, wave = tid >> 6, r = lane & 15, g = lane >> 4;
    const int tok0 = tile * 64;
    LAS bf16_t* lin = (LAS bf16_t*)c.lds;
    const float* mu = c.in(3) + l * 1056;
    const bf16_t* P = c.P();
#pragma unroll
    for (int q = 0; q < 5; ++q) {
        const int pc = tid + 512 * q;
        if (pc < 64 * 36) {
            const int tk = pc / 36, j8 = pc - tk * 36; const int tok = tok0 + tk, col = C_LORA + j8 * 8;
            const u32x4 cu = *(const u32x4*)(P + (size_t)tok * PLD + col);
            u32x4 pr = (u32x4){0u, 0u, 0u, 0u}; if ((tok & (SEQ - 1)) != 0) pr = *(const u32x4*)(P + (size_t)(tok - 1) * PLD + col);
            const f32x4 m0 = *(const f32x4*)(mu + col), m1 = *(const f32x4*)(mu + col + 4);
            float v[8];
            v[0] = bflo(cu.x) + (bflo(pr.x) - bflo(cu.x)) * m0[0]; v[1] = bfhi(cu.x) + (bfhi(pr.x) - bfhi(cu.x)) * m0[1];
            v[2] = bflo(cu.y) + (bflo(pr.y) - bflo(cu.y)) * m0[2]; v[3] = bfhi(cu.y) + (bfhi(pr.y) - bfhi(cu.y)) * m0[3];
            v[4] = bflo(cu.z) + (bflo(pr.z) - bflo(cu.z)) * m1[0]; v[5] = bfhi(cu.z) + (bfhi(pr.z) - bfhi(cu.z)) * m1[1];
            v[6] = bflo(cu.w) + (bflo(pr.w) - bflo(cu.w)) * m1[2]; v[7] = bfhi(cu.w) + (bfhi(pr.w) - bfhi(cu.w)) * m1[3];
            if (j8 < 8) {
#pragma unroll
                for (int i = 0; i < 8; ++i) { const float e2 = __expf(2.f * v[i]); v[i] = 1.f - 2.f / (e2 + 1.f); }
            } else if (j8 >= 16) {
#pragma unroll
                for (int i = 0; i < 8; ++i) v[i] = sigmoidf_(v[i]);
            }
            u32x4 w; w.x = pack2(v[0], v[1]); w.y = pack2(v[2], v[3]); w.z = pack2(v[4], v[5]); w.w = pack2(v[6], v[7]);
            *(LAS u32x4*)(lin + tk * 296 + j8 * 8) = w;
        }
    }
    __syncthreads();
    const int h = wave & 3, th = wave >> 2;
    const bf16_t* LT = c.LoraT();
    f32x4 accW[2][4], accA[2][4], accG[2][4];
#pragma unroll
    for (int mt = 0; mt < 2; ++mt)
#pragma unroll
        for (int nt = 0; nt < 4; ++nt) { accW[mt][nt] = (f32x4){0.f, 0.f, 0.f, 0.f}; accA[mt][nt] = (f32x4){0.f, 0.f, 0.f, 0.f}; accG[mt][nt] = (f32x4){0.f, 0.f, 0.f, 0.f}; }
#pragma unroll
    for (int ks = 0; ks < 9; ++ks) {
        bf16x8 af[2];
#pragma unroll
        for (int mt = 0; mt < 2; ++mt) af[mt] = *(const LAS bf16x8*)(lin + (th * 32 + mt * 16 + r) * 296 + ks * 32 + 8 * g);
#pragma unroll
        for (int nt = 0; nt < 4; ++nt) {
            const int n = h * 64 + nt * 16 + r;
            const bf16x8 bfr = *(const bf16x8*)(LT + n * 288 + ks * 32 + 8 * g);
#pragma unroll
            for (int mt = 0; mt < 2; ++mt) {
                if (ks < 2) accW[mt][nt] = __builtin_amdgcn_mfma_f32_16x16x32_bf16(af[mt], bfr, accW[mt][nt], 0, 0, 0);
                else if (ks < 4) accA[mt][nt] = __builtin_amdgcn_mfma_f32_16x16x32_bf16(af[mt], bfr, accA[mt][nt], 0, 0, 0);
                else accG[mt][nt] = __builtin_amdgcn_mfma_f32_16x16x32_bf16(af[mt], bfr, accG[mt][nt], 0, 0, 0);
            }
        }
    }
    const float* w0 = c.in(4) + l * 256; const float* a0 = c.in(6) + l * 256; const float* kkp = c.in(9) + l * 256; const float* kap = c.in(10) + l * 256; const float* rkp = c.in(11) + l * 256;
    float w0v[4], a0v[4], kkv[4], kav[4], rkv[4], mur[4], muk[4], muv[4];
#pragma unroll
    for (int nt = 0; nt < 4; ++nt) { const int n = h * 64 + nt * 16 + r; w0v[nt] = w0[n]; a0v[nt] = a0[n]; kkv[nt] = kkp[n]; kav[nt] = kap[n]; rkv[nt] = rkp[n]; mur[nt] = mu[C_RWR + n]; muk[nt] = mu[C_RWK + n]; muv[nt] = mu[C_RWV + n]; }
#pragma unroll
    for (int mt = 0; mt < 2; ++mt)
#pragma unroll
        for (int reg = 0; reg < 4; ++reg) {
            const int tok = tok0 + th * 32 + mt * 16 + 4 * g + reg; const bool first = (tok & (SEQ - 1)) == 0;
            const bf16_t* pc = P + (size_t)tok * PLD; const bf16_t* pp = pc - PLD;
            float ssk = 0.f, bon = 0.f, kkn[4], av[4];
#pragma unroll
            for (int nt = 0; nt < 4; ++nt) {
                const int n = h * 64 + nt * 16 + r;
                const float cr = bf2f(pc[C_RWR + n]), ck = bf2f(pc[C_RWK + n]), cv = bf2f(pc[C_RWV + n]);
                const float qr = first ? 0.f : bf2f(pp[C_RWR + n]), qk = first ? 0.f : bf2f(pp[C_RWK + n]), qv = first ? 0.f : bf2f(pp[C_RWV + n]);
                const float rr = cr + (qr - cr) * mur[nt], kx = ck + (qk - ck) * muk[nt], vx = cv + (qv - cv) * muv[nt];
                const float pre = w0v[nt] + accW[mt][nt][reg];
                const float wlog = logsigf_(pre) - 0.5f;
                const float dec = __expf(-__expf(wlog));
                const float a = sigmoidf_(a0v[nt] + accA[mt][nt][reg]);
                const float kk_ = kx * kkv[nt]; ssk += kk_ * kk_;
                const float km = kx * (1.f + (a - 1.f) * kav[nt]);
                bon += rr * km * rkv[nt];
                const size_t o = (size_t)tok * 256 + n;
                c.DEC()[o] = dec; c.R()[o] = f2bf(rr); c.KM()[o] = f2bf(km); c.V()[o] = f2bf(vx); c.Gg()[o] = f2bf(accG[mt][nt][reg]);
                kkn[nt] = kk_; av[nt] = a;
            }
            ssk = rsum16(ssk); bon = rsum16(bon);
            const float inv = 1.f / fmaxf(sqrtf(ssk), 1e-12f);
#pragma unroll
            for (int nt = 0; nt < 4; ++nt) { const size_t o = (size_t)tok * 256 + h * 64 + nt * 16 + r; const float kn = kkn[nt] * inv; c.AN()[o] = f2bf(-kn); c.BN()[o] = f2bf(kn * av[nt]); }
            if (r == 0) c.BON()[(size_t)tok * 4 + h] = bon;
        }
    __syncthreads();
}

__device__ __forceinline__ void conv_tile(const Ctx& c, int l, int tile) {
    const int tid = otid(), lane = tid & 63, wave = tid >> 6;
    const int tok0 = tile * 32, t0 = tok0 & (SEQ - 1);
    LAS float* ub = (LAS float*)c.lds;
    LAS float* ob = ub + 62 * 256;
    const bf16_t* P = c.P();
#pragma unroll
    for (int q = 0; q < 4; ++q) {
        const int pc = tid + 512 * q;
        if (pc < 62 * 32) {
            const int row = pc >> 5, c8 = (pc & 31) * 8;
            f32x4 o0 = (f32x4){0.f, 0.f, 0.f, 0.f}, o1 = (f32x4){0.f, 0.f, 0.f, 0.f};
            if (t0 - 30 + row >= 0) { const size_t tok = (size_t)(tok0 - 30 + row);
                const u32x4 a = *(const u32x4*)(P + tok * PLD + C_CVA + c8), b = *(const u32x4*)(P + tok * PLD + C_CVB + c8);
                o0[0] = bflo(a.x) * sigmoidf_(bflo(b.x)); o0[1] = bfhi(a.x) * sigmoidf_(bfhi(b.x)); o0[2] = bflo(a.y) * sigmoidf_(bflo(b.y)); o0[3] = bfhi(a.y) * sigmoidf_(bfhi(b.y));
                o1[0] = bflo(a.z) * sigmoidf_(bflo(b.z)); o1[1] = bfhi(a.z) * sigmoidf_(bfhi(b.z)); o1[2] = bflo(a.w) * sigmoidf_(bflo(b.w)); o1[3] = bfhi(a.w) * sigmoidf_(bfhi(b.w)); }
            *(LAS f32x4*)(ub + row * 256 + c8) = o0; *(LAS f32x4*)(ub + row * 256 + c8 + 4) = o1;
        }
    }
    __syncthreads();
    { const int ch = tid & 255, tg = tid >> 8;
      const float* cw_ = c.in(15) + (size_t)l * 31 * 256; float cw[31];
#pragma unroll
      for (int w = 0; w < 31; ++w) cw[w] = cw_[w * 256 + ch];
      const float bias = c.in(16)[l * 256 + ch];
      for (int tt = 0; tt < 16; ++tt) { const int tl = tg * 16 + tt; float acc = bias;
#pragma unroll
          for (int w = 0; w < 31; ++w) acc += ub[(tl + w) * 256 + ch] * cw[w];
          ob[tl * 256 + ch] = acc; } }
    __syncthreads();
    { const f32x4 gv = *(const f32x4*)(c.in(17) + l * 256 + 4 * lane), bv = *(const f32x4*)(c.in(18) + l * 256 + 4 * lane);
      bf16_t* Yc = c.Y() + (size_t)1 * NTOK * 256;
      for (int q = 0; q < 4; ++q) { const int tl = wave * 4 + q;
          const f32x4 x = *(const LAS f32x4*)(ob + tl * 256 + 4 * lane);
          const float mean = wsum64((x[0] + x[1]) + (x[2] + x[3])) * (1.f / 256.f);
          const f32x4 d = x - mean;
          const float var = wsum64((d[0] * d[0] + d[1] * d[1]) + (d[2] * d[2] + d[3] * d[3])) * (1.f / 256.f);
          const float rstd = rsqrtf(var + LN_EPS);
          f32x4 y = d * rstd * gv + bv;
          u32x2 w; w.x = pack2(siluf_(y[0]), siluf_(y[1])); w.y = pack2(siluf_(y[2]), siluf_(y[3]));
          *(u32x2*)(Yc + (size_t)(tok0 + tl) * 256 + 4 * lane) = w; } }
    __syncthreads();
}

__device__ __forceinline__ void fox_cumsum(const Ctx& c, int l, int b) {
    const int tid = otid(), lane = tid & 63, wave = tid >> 6;
    LAS float* wt = (LAS float*)c.lds;
    const f32x4 bf = *(const f32x4*)(c.in(24) + l * 4);
    f32x4 pre[4]; f32x4 run = (f32x4){0.f, 0.f, 0.f, 0.f};
#pragma unroll
    for (int i = 0; i < 4; ++i) { const size_t tok = (size_t)b * SEQ + tid * 4 + i; const u32x2 z = *(const u32x2*)(c.P() + tok * PLD + C_FZ);
        run[0] += logsigf_(bflo(z.x) + bf[0]); run[1] += logsigf_(bfhi(z.x) + bf[1]); run[2] += logsigf_(bflo(z.y) + bf[2]); run[3] += logsigf_(bfhi(z.y) + bf[3]); pre[i] = run; }
    f32x4 inc = run;
#pragma unroll
    for (int off = 1; off < 64; off <<= 1) {
#pragma unroll
        for (int hh = 0; hh < 4; ++hh) { const float t = __shfl_up(inc[hh], off); if (lane >= off) inc[hh] += t; } }
    if (lane == 63) { wt[wave * 4 + 0] = inc[0]; wt[wave * 4 + 1] = inc[1]; wt[wave * 4 + 2] = inc[2]; wt[wave * 4 + 3] = inc[3]; }
    __syncthreads();
    f32x4 base = inc - run;
    for (int w = 0; w < wave; ++w) { base[0] += wt[w * 4 + 0]; base[1] += wt[w * 4 + 1]; base[2] += wt[w * 4 + 2]; base[3] += wt[w * 4 + 3]; }
#pragma unroll
    for (int i = 0; i < 4; ++i) { const size_t tok = (size_t)b * SEQ + tid * 4 + i; *(f32x4*)(c.CF() + tok * 4) = pre[i] + base; }
    __syncthreads();
}

__device__ __forceinline__ void rw_scan_item(const Ctx& c, int item) {
    const int tid = otid(), lane = tid & 63, wave = __builtin_amdgcn_readfirstlane(tid >> 6);
    const int qr = item & 3, h = (item >> 2) & 3, b = item >> 4;
    const int cb = h * 64, rb = qr * 16; const size_t tokb = (size_t)b * SEQ;
    LAS float* L = (LAS float*)c.lds;
    constexpr int BUFSZ = 10752;
    LAS float* ybase = L + 2 * BUFSZ;
    constexpr int NCH = SEQ / 32;
    if (wave < 4) {
        const int jg = lane & 15, rA = wave * 4 + (lane >> 4);
        f32x2 SaA = (f32x2){0.f, 0.f}, SbA = (f32x2){0.f, 0.f};
        __syncthreads();
        for (int cc = 0; cc < NCH; ++cc) {
            const LAS float* buf = L + (cc & 1) * BUFSZ; LAS float* ybuf = ybase + (cc & 1) * 512;
            const LAS float* bj = buf + 4 * jg; const LAS float* bv = buf + 10240 + rA;
            f32x4 w4 = *(const LAS f32x4*)(bj), k4 = *(const LAS f32x4*)(bj + 2048), a4 = *(const LAS f32x4*)(bj + 4096), b4 = *(const LAS f32x4*)(bj + 6144), r4 = *(const LAS f32x4*)(bj + 8192);
            float vi = bv[0], ykA = 0.f;
#pragma unroll
            for (int st = 0; st < 32; ++st) {
                const f32x4 nw4 = *(const LAS f32x4*)(bj + (st + 1) * 64), nk4 = *(const LAS f32x4*)(bj + 2048 + (st + 1) * 64), na4 = *(const LAS f32x4*)(bj + 4096 + (st + 1) * 64),
                            nb4 = *(const LAS f32x4*)(bj + 6144 + (st + 1) * 64), nr4 = *(const LAS f32x4*)(bj + 8192 + (st + 1) * 64);
                const float nvi = bv[(st + 1) * 16];
                const f32x2 a01 = (f32x2){a4[0], a4[1]}, a23 = (f32x2){a4[2], a4[3]}, w01 = (f32x2){w4[0], w4[1]}, w23 = (f32x2){w4[2], w4[3]}, k01 = (f32x2){k4[0], k4[1]}, k23 = (f32x2){k4[2], k4[3]};
                const f32x2 b01 = (f32x2){b4[0], b4[1]}, b23 = (f32x2){b4[2], b4[3]}, r01 = (f32x2){r4[0], r4[1]}, r23 = (f32x2){r4[2], r4[3]};
                const f32x2 dA = SaA * a01 + SbA * a23;
                const f32x2 taA = SaA * w01 + vi * k01, tbA = SbA * w23 + vi * k23;
                const float saA = dsum16(dA.x + dA.y);
                SaA = saA * b01 + taA; SbA = saA * b23 + tbA;
                const f32x2 yA2 = SaA * r01 + SbA * r23;
                const float yA = dsum16(yA2.x + yA2.y);
                ykA = ((st & 15) == jg) ? yA : ykA;
                if ((st & 15) == 15) ybuf[(st - 15 + jg) * 16 + rA] = ykA;
                w4 = nw4; k4 = nk4; a4 = na4; b4 = nb4; r4 = nr4; vi = nvi;
            }
            __syncthreads();
        }
        __syncthreads();
    } else {
        const int ft = tid - 256;
        f32x4 sd[2]; u32x4 sk, sa, sb, sr, sv;
#define RW_LOAD(cc_) do { const size_t tb_ = tokb + (size_t)(cc_) * 32; \
            _Pragma("unroll") for (int q = 0; q < 2; ++q) { const int pc = ft + 256 * q; sd[q] = *(const f32x4*)(c.DEC() + (tb_ + (pc >> 4)) * 256 + cb + (pc & 15) * 4); } \
            { const size_t o_ = (tb_ + (ft >> 3)) * 256 + cb + (ft & 7) * 8; sk = *(const u32x4*)(c.KM() + o_); sa = *(const u32x4*)(c.AN() + o_); sb = *(const u32x4*)(c.BN() + o_); sr = *(const u32x4*)(c.R() + o_); } \
            if (ft < 64) sv = *(const u32x4*)(c.V() + (tb_ + (ft >> 1)) * 256 + cb + rb + (ft & 1) * 8); } while (0)
#define RW_PUT8(dst, v_) do { *(LAS f32x4*)(dst) = (f32x4){bflo((v_).x), bfhi((v_).x), bflo((v_).y), bfhi((v_).y)}; *(LAS f32x4*)((dst) + 4) = (f32x4){bflo((v_).z), bfhi((v_).z), bflo((v_).w), bfhi((v_).w)}; } while (0)
#define RW_STAGE(cc_) do { LAS float* B_ = L + ((cc_) & 1) * BUFSZ; \
            _Pragma("unroll") for (int q = 0; q < 2; ++q) { const int pc = ft + 256 * q; *(LAS f32x4*)(B_ + (pc >> 4) * 64 + (pc & 15) * 4) = sd[q]; } \
            { LAS float* d_ = B_ + (ft >> 3) * 64 + (ft & 7) * 8; RW_PUT8(d_ + 2048, sk); RW_PUT8(d_ + 4096, sa); RW_PUT8(d_ + 6144, sb); RW_PUT8(d_ + 8192, sr); } \
            if (ft < 64) { LAS float* d_ = B_ + 10240 + (ft >> 1) * 16 + (ft & 1) * 8; RW_PUT8(d_, sv); } } while (0)
#define RW_YOUT(cc_) do { if (ft < 128) { const f32x4 y_ = *(const LAS f32x4*)(ybase + ((cc_) & 1) * 512 + (ft >> 2) * 16 + (ft & 3) * 4); \
            *(f32x4*)(c.YRAW() + (tokb + (size_t)(cc_) * 32 + (ft >> 2)) * 256 + cb + rb + (ft & 3) * 4) = y_; } } while (0)
        RW_LOAD(0); RW_STAGE(0); RW_LOAD(1);
        __syncthreads();
        for (int cc = 0; cc < NCH; ++cc) {
            if (cc + 1 < NCH) RW_STAGE(cc + 1);
            if (cc + 2 < NCH) RW_LOAD(cc + 2);
            if (cc > 0) RW_YOUT(cc - 1);
            __syncthreads();
        }
        RW_YOUT(NCH - 1);
        __syncthreads();
#undef RW_LOAD
#undef RW_PUT8
#undef RW_STAGE
#undef RW_YOUT
    }
}

__device__ __forceinline__ void gla_item(const Ctx& c, int l, int item) {
    const int tid = otid(), lane = tid & 63, wave = __builtin_amdgcn_readfirstlane(tid >> 6);
    const int h = item & 3, b = item >> 2; const size_t tokb = (size_t)b * SEQ;
    LAS float* L = (LAS float*)c.lds;
    LAS float* obase = L + 2 * 10240;
    const bf16_t* P = c.P();
    bf16_t* Yg = c.Y() + (size_t)2 * NTOK * 256;
    constexpr int NCH = SEQ / 64;
    if (wave < 4) {
        const int vl = lane >> 3, dq = lane & 7;
        f32x2 Sa0 = (f32x2){0.f, 0.f}, Sb0 = (f32x2){0.f, 0.f}, Sa1 = (f32x2){0.f, 0.f}, Sb1 = (f32x2){0.f, 0.f};
        __syncthreads();
        for (int cc = 0; cc < NCH; ++cc) {
            const LAS float* B = L + (cc & 1) * 10240; LAS float* ob = obase + (cc & 1) * 4096;
            const LAS float* pq = B + 4 * dq; const LAS float* pk = B + 2048 + 4 * dq; const LAS float* pa = B + 4096 + 4 * dq; const LAS float* pv = B + 6144 + wave * 16 + 2 * vl;
            f32x4 a4 = *(const LAS f32x4*)pa, k4 = *(const LAS f32x4*)pk, q4 = *(const LAS f32x4*)pq; f32x2 vv = *(const LAS f32x2*)pv; float ok0 = 0.f, ok1 = 0.f;
#pragma unroll 16
            for (int st = 0; st < 64; ++st) {
                const int sn = (st + 1) & 63;
                const f32x4 na4 = *(const LAS f32x4*)(pa + sn * 32), nk4 = *(const LAS f32x4*)(pk + sn * 32), nq4 = *(const LAS f32x4*)(pq + sn * 32); const f32x2 nvv = *(const LAS f32x2*)(pv + sn * 64);
                const f32x2 a01 = (f32x2){a4[0], a4[1]}, a23 = (f32x2){a4[2], a4[3]}, k01 = (f32x2){k4[0], k4[1]}, k23 = (f32x2){k4[2], k4[3]}, q01 = (f32x2){q4[0], q4[1]}, q23 = (f32x2){q4[2], q4[3]};
                Sa0 = Sa0 * a01 + vv.x * k01; Sb0 = Sb0 * a23 + vv.x * k23;
                Sa1 = Sa1 * a01 + vv.y * k01; Sb1 = Sb1 * a23 + vv.y * k23;
                const f32x2 o0 = Sa0 * q01 + Sb0 * q23, o1 = Sa1 * q01 + Sb1 * q23;
                const float r0 = dsum8(o0.x + o0.y), r1 = dsum8(o1.x + o1.y);
                ok0 = ((st & 7) == dq) ? r0 : ok0; ok1 = ((st & 7) == dq) ? r1 : ok1;
                if ((st & 7) == 7) *(LAS f32x2*)(ob + (st - 7 + dq) * 64 + wave * 16 + 2 * vl) = (f32x2){ok0, ok1};
                a4 = na4; k4 = nk4; q4 = nq4; vv = nvv;
            }
            __syncthreads();
        }
        __syncthreads();
    } else {
        const int ft = tid - 256;
        const float* a2 = c.in(20) + (size_t)l * 16 * 128; const float* ab = c.in(21) + l * 128;
        float a2c[16];
#pragma unroll
        for (int j = 0; j < 16; ++j) a2c[j] = a2[j * 128 + h * 32 + (ft & 31)];
        const float abv = ab[h * 32 + (ft & 31)];
        const int nvq = ft & 3;
        f32x4 lg[4];
#pragma unroll
        for (int i = 0; i < 4; ++i) lg[i] = *(const f32x4*)(c.in(22) + l * 256 + h * 64 + nvq * 16 + 4 * i);
        u32x4 rq, rk, rv[2], rz[16], rg0, rg1;
#define GLA_LOAD(cc_) do { const size_t tb_ = tokb + (size_t)(cc_) * 64; \
            _Pragma("unroll") for (int i = 0; i < 8; ++i) { const bf16_t* gp = P + (tb_ + (ft >> 5) * 8 + i) * PLD + C_GZ; rz[2 * i] = *(const u32x4*)gp; rz[2 * i + 1] = *(const u32x4*)(gp + 8); } \
            rq = *(const u32x4*)(P + (tb_ + (ft >> 2)) * PLD + C_GQ + h * 32 + (ft & 3) * 8); rk = *(const u32x4*)(P + (tb_ + (ft >> 2)) * PLD + C_GK + h * 32 + (ft & 3) * 8); \
            _Pragma("unroll") for (int q = 0; q < 2; ++q) { const int pc = ft + 256 * q; rv[q] = *(const u32x4*)(P + (tb_ + (pc >> 3)) * PLD + C_GV + h * 64 + (pc & 7) * 8); } } while (0)
#define GLA_STAGE(cc_) do { LAS float* B_ = L + ((cc_) & 1) * 10240; const size_t tb_ = tokb + (size_t)(cc_) * 64; const float qsc = 0.17677669529663687f; \
            { LAS float* d_ = B_ + (ft >> 2) * 32 + (ft & 3) * 8; \
              *(LAS f32x4*)d_ = (f32x4){bflo(rq.x) * qsc, bfhi(rq.x) * qsc, bflo(rq.y) * qsc, bfhi(rq.y) * qsc}; *(LAS f32x4*)(d_ + 4) = (f32x4){bflo(rq.z) * qsc, bfhi(rq.z) * qsc, bflo(rq.w) * qsc, bfhi(rq.w) * qsc}; \
              *(LAS f32x4*)(d_ + 2048) = (f32x4){bflo(rk.x), bfhi(rk.x), bflo(rk.y), bfhi(rk.y)}; *(LAS f32x4*)(d_ + 2052) = (f32x4){bflo(rk.z), bfhi(rk.z), bflo(rk.w), bfhi(rk.w)}; } \
            _Pragma("unroll") for (int q = 0; q < 2; ++q) { const int pc = ft + 256 * q; LAS float* d_ = B_ + 6144 + (pc >> 3) * 64 + (pc & 7) * 8; \
              *(LAS f32x4*)d_ = (f32x4){bflo(rv[q].x), bfhi(rv[q].x), bflo(rv[q].y), bfhi(rv[q].y)}; *(LAS f32x4*)(d_ + 4) = (f32x4){bflo(rv[q].z), bfhi(rv[q].z), bflo(rv[q].w), bfhi(rv[q].w)}; } \
              \
            _Pragma("unroll") for (int i = 0; i < 8; ++i) { const int t_ = (ft >> 5) * 8 + i; \
              const u32x4 z0 = rz[2 * i], z1 = rz[2 * i + 1]; \
              float z = abv; \
              z += bflo(z0.x) * a2c[0] + bfhi(z0.x) * a2c[1] + bflo(z0.y) * a2c[2] + bfhi(z0.y) * a2c[3] + bflo(z0.z) * a2c[4] + bfhi(z0.z) * a2c[5] + bflo(z0.w) * a2c[6] + bfhi(z0.w) * a2c[7]; \
              z += bflo(z1.x) * a2c[8] + bfhi(z1.x) * a2c[9] + bflo(z1.y) * a2c[10] + bfhi(z1.y) * a2c[11] + bflo(z1.z) * a2c[12] + bfhi(z1.z) * a2c[13] + bflo(z1.w) * a2c[14] + bfhi(z1.w) * a2c[15]; \
              B_[4096 + t_ * 32 + (ft & 31)] = __builtin_amdgcn_exp2f(__builtin_amdgcn_logf(1.f + __expf(-z)) * (-1.f / 16.f)); } } while (0)
#define GLA_NORM(cc_) do { const LAS float* ob_ = obase + ((cc_) & 1) * 4096 + (ft >> 2) * 64 + nvq * 16; const size_t tok_ = tokb + (size_t)(cc_) * 64 + (ft >> 2); \
            const u32x4 g0 = rg0, g1 = rg1; \
            f32x4 o_[4]; float ss = 0.f; \
            _Pragma("unroll") for (int i = 0; i < 4; ++i) { o_[i] = *(const LAS f32x4*)(ob_ + 4 * i); ss += (o_[i][0] * o_[i][0] + o_[i][1] * o_[i][1]) + (o_[i][2] * o_[i][2] + o_[i][3] * o_[i][3]); } \
            ss += dpp_mov<0xB1>(ss); ss += dpp_mov<0x4E>(ss); \
            const float rs = rsqrtf(ss * (1.f / 64.f) + 1e-5f); \
            u32x4 w0, w1; \
            w0.x = pack2(o_[0][0] * rs * lg[0][0] * siluf_(bflo(g0.x)), o_[0][1] * rs * lg[0][1] * siluf_(bfhi(g0.x))); w0.y = pack2(o_[0][2] * rs * lg[0][2] * siluf_(bflo(g0.y)), o_[0][3] * rs * lg[0][3] * siluf_(bfhi(g0.y))); \
            w0.z = pack2(o_[1][0] * rs * lg[1][0] * siluf_(bflo(g0.z)), o_[1][1] * rs * lg[1][1] * siluf_(bfhi(g0.z))); w0.w = pack2(o_[1][2] * rs * lg[1][2] * siluf_(bflo(g0.w)), o_[1][3] * rs * lg[1][3] * siluf_(bfhi(g0.w))); \
            w1.x = pack2(o_[2][0] * rs * lg[2][0] * siluf_(bflo(g1.x)), o_[2][1] * rs * lg[2][1] * siluf_(bfhi(g1.x))); w1.y = pack2(o_[2][2] * rs * lg[2][2] * siluf_(bflo(g1.y)), o_[2][3] * rs * lg[2][3] * siluf_(bfhi(g1.y))); \
            w1.z = pack2(o_[3][0] * rs * lg[3][0] * siluf_(bflo(g1.z)), o_[3][1] * rs * lg[3][1] * siluf_(bfhi(g1.z))); w1.w = pack2(o_[3][2] * rs * lg[3][2] * siluf_(bflo(g1.w)), o_[3][3] * rs * lg[3][3] * siluf_(bfhi(g1.w))); \
            bf16_t* yp_ = Yg + tok_ * 256 + h * 64 + nvq * 16; *(u32x4*)yp_ = w0; *(u32x4*)(yp_ + 8) = w1; } while (0)
#define GLA_GRLOAD(cc_) do { const bf16_t* gp_ = P + (tokb + (size_t)(cc_) * 64 + (ft >> 2)) * PLD + C_GR + h * 64 + nvq * 16; rg0 = *(const u32x4*)gp_; rg1 = *(const u32x4*)(gp_ + 8); } while (0)
        GLA_LOAD(0); GLA_STAGE(0); GLA_LOAD(1);
        __syncthreads();
        for (int cc = 0; cc < NCH; ++cc) {
            if (cc > 0) GLA_GRLOAD(cc - 1);
            if (cc + 1 < NCH) GLA_STAGE(cc + 1);
            if (cc + 2 < NCH) GLA_LOAD(cc + 2);
            if (cc > 0) GLA_NORM(cc - 1);
            __syncthreads();
        }
        GLA_GRLOAD(NCH - 1); GLA_NORM(NCH - 1);
        __syncthreads();
#undef GLA_GRLOAD
#undef GLA_LOAD
#undef GLA_STAGE
#undef GLA_NORM
    }
}

template <int D, bool FOX>
__device__ __forceinline__ void attn_block(LAS unsigned char* lds, const bf16_t* Q, int ldq, const bf16_t* Kp, int ldk, const bf16_t* Vp, int ldv,
                                           bf16_t* O, int ldo, int q0, int nkeys, float scale, const float* cvec) {
    constexpr int KLD = D + 8, VLD = 72, NKS = D / 32, NDT = D / 16;
    const int tid = otid(), lane = tid & 63, wave = tid >> 6, r = lane & 15, g = lane >> 4;
    LAS bf16_t* Ks = (LAS bf16_t*)lds;
    LAS bf16_t* Vt = Ks + 64 * KLD;
    LAS float* ckb = (LAS float*)(Vt + D * VLD);
    const int qrow = q0 + 16 * wave + r;
    bf16x8 Qf[NKS];
#pragma unroll
    for (int ks = 0; ks < NKS; ++ks) Qf[ks] = *(const bf16x8*)(Q + (size_t)qrow * ldq + ks * 32 + 8 * g);
    float cq = 0.f; if (FOX) cq = cvec[(size_t)qrow * 4];
    f32x4 Oacc[NDT];
#pragma unroll
    for (int dt = 0; dt < NDT; ++dt) Oacc[dt] = (f32x4){0.f, 0.f, 0.f, 0.f};
    float mrun = -1e30f, lsum = 0.f;
    const int nch = nkeys / 64;
    constexpr int NQ = (64 * D / 8) / 512;
    u32x4 kreg[NQ], vreg[NQ]; float ckr = 0.f;
#define ATT_LOAD(chn) do { const int k0_ = (chn) * 64; \
        _Pragma("unroll") for (int q = 0; q < NQ; ++q) { const int pidx = tid + 512 * q; const int key = pidx / (D / 8), dc = pidx % (D / 8); \
            kreg[q] = *(const u32x4*)(Kp + (size_t)(k0_ + key) * ldk + dc * 8); vreg[q] = *(const u32x4*)(Vp + (size_t)(k0_ + key) * ldv + dc * 8); } \
        if (FOX) { if (tid < 64) ckr = cvec[(size_t)(k0_ + tid) * 4]; } } while (0)
    ATT_LOAD(0);
    for (int ch = 0; ch < nch; ++ch) {
        const int key0 = ch * 64;
#pragma unroll
        for (int q = 0; q < NQ; ++q) { const int pidx = tid + 512 * q; const int key = pidx / (D / 8), dc = pidx % (D / 8);
            *(LAS u32x4*)(Ks + key * KLD + dc * 8) = kreg[q];
            const u32x4 vv = vreg[q];
            LAS bf16_t* vd = Vt + (dc * 8) * VLD + (key ^ ((dc & 15) << 2));
            vd[0 * VLD] = (bf16_t)(vv.x & 0xffff); vd[1 * VLD] = (bf16_t)(vv.x >> 16); vd[2 * VLD] = (bf16_t)(vv.y & 0xffff); vd[3 * VLD] = (bf16_t)(vv.y >> 16);
            vd[4 * VLD] = (bf16_t)(vv.z & 0xffff); vd[5 * VLD] = (bf16_t)(vv.z >> 16); vd[6 * VLD] = (bf16_t)(vv.w & 0xffff); vd[7 * VLD] = (bf16_t)(vv.w >> 16); }
        if (FOX) { if (tid < 64) ckb[tid] = ckr; }
        __syncthreads();
        if (ch + 1 < nch) ATT_LOAD(ch + 1);
        const bool active = !FOX || (key0 <= q0 + 16 * wave + 15);
        if (active) {
            f32x4 s[4];
#pragma unroll
            for (int kt = 0; kt < 4; ++kt) { f32x4 a = (f32x4){0.f, 0.f, 0.f, 0.f};
#pragma unroll
                for (int ks = 0; ks < NKS; ++ks) { const bf16x8 kf = *(const LAS bf16x8*)(Ks + (kt * 16 + r) * KLD + ks * 32 + 8 * g);
                    a = __builtin_amdgcn_mfma_f32_16x16x32_bf16(kf, Qf[ks], a, 0, 0, 0); }
                s[kt] = a; }
            float mx = -1e30f;
#pragma unroll
            for (int kt = 0; kt < 4; ++kt)
#pragma unroll
                for (int reg = 0; reg < 4; ++reg) { float v = s[kt][reg] * scale;
                    if (FOX) { const int kl = kt * 16 + 4 * g + reg; v += cq - ckb[kl]; if (key0 + kl > qrow) v = -1e30f; }
                    s[kt][reg] = v; mx = fmaxf(mx, v); }
            mx = fmaxf(mx, __shfl_xor(mx, 16)); mx = fmaxf(mx, __shfl_xor(mx, 32));
            const float mnew = fmaxf(mrun, mx); const float corr = __expf(mrun - mnew); mrun = mnew;
            float ps = 0.f;
#pragma unroll
            for (int kt = 0; kt < 4; ++kt)
#pragma unroll
                for (int reg = 0; reg < 4; ++reg) { const float pv = __expf(s[kt][reg] - mnew); s[kt][reg] = pv; ps += pv; }
            lsum = lsum * corr + ps;
            bf16x8 pf[2];
#pragma unroll
            for (int s2 = 0; s2 < 2; ++s2) {
                u32x4 w; w.x = pack2(s[2 * s2][0], s[2 * s2][1]); w.y = pack2(s[2 * s2][2], s[2 * s2][3]); w.z = pack2(s[2 * s2 + 1][0], s[2 * s2 + 1][1]); w.w = pack2(s[2 * s2 + 1][2], s[2 * s2 + 1][3]);
                pf[s2] = __builtin_bit_cast(bf16x8, w); }
#pragma unroll
            for (int dt = 0; dt < NDT; ++dt) { f32x4 o = Oacc[dt] * corr;
#pragma unroll
                for (int s2 = 0; s2 < 2; ++s2) { const int sw = ((dt * 2 + (r >> 3)) & 15) << 2; const LAS bf16_t* vrow = Vt + (dt * 16 + r) * VLD;
                    const u32x2 lo = *(const LAS u32x2*)(vrow + ((s2 * 32 + 4 * g) ^ sw)), hi = *(const LAS u32x2*)(vrow + ((s2 * 32 + 16 + 4 * g) ^ sw));
                    u32x4 w; w.x = lo.x; w.y = lo.y; w.z = hi.x; w.w = hi.y;
                    o = __builtin_amdgcn_mfma_f32_16x16x32_bf16(__builtin_bit_cast(bf16x8, w), pf[s2], o, 0, 0, 0); }
                Oacc[dt] = o; }
        }
        __syncthreads();
    }
#undef ATT_LOAD
    lsum += __shfl_xor(lsum, 16); lsum += __shfl_xor(lsum, 32);
    const float inv = 1.f / lsum;
#pragma unroll
    for (int dt = 0; dt < NDT; ++dt) { u32x2 w; w.x = pack2(Oacc[dt][0] * inv, Oacc[dt][1] * inv); w.y = pack2(Oacc[dt][2] * inv, Oacc[dt][3] * inv);
        *(u32x2*)(O + (size_t)qrow * ldo + dt * 16 + 4 * g) = w; }
}

__device__ __forceinline__ void xattn_block(LAS unsigned char* lds, const bf16_t* Q, const bf16_t* Kp, const bf16_t* Vp, bf16_t* O, int q0) {
    constexpr int D = 256, KLD = D + 8, VLD = 72, ldq = 1024, ldk = 8192, ldo = 1024;
    const int tid = otid(), lane = tid & 63, wave = tid >> 6, r = lane & 15, g = lane >> 4;
    LAS bf16_t* Ks = (LAS bf16_t*)lds;
    LAS bf16_t* Vt = Ks + 64 * KLD;
    const int qrow = q0 + 16 * wave + r;
    u32x4 stg[4];
#define XA_LOAD(src, chn) do { _Pragma("unroll") for (int q = 0; q < 4; ++q) { const int pidx = tid + 512 * q; const int key = pidx >> 5, dc = pidx & 31; \
        stg[q] = *(const u32x4*)((src) + (size_t)((chn) * 64 + key) * ldk + dc * 8); } } while (0)
    XA_LOAD(Kp, 0);
    bf16x8 pf[8];
    {
        bf16x8 Qf[8];
#pragma unroll
        for (int ks = 0; ks < 8; ++ks) Qf[ks] = *(const bf16x8*)(Q + (size_t)qrow * ldq + ks * 32 + 8 * g);
        f32x4 s[16];
#pragma unroll
        for (int ch = 0; ch < 4; ++ch) {
#pragma unroll
            for (int q = 0; q < 4; ++q) { const int pidx = tid + 512 * q; const int key = pidx >> 5, dc = pidx & 31; *(LAS u32x4*)(Ks + key * KLD + dc * 8) = stg[q]; }
            __syncthreads();
            if (ch < 3) XA_LOAD(Kp, ch + 1); else XA_LOAD(Vp, 0);
#pragma unroll
            for (int kt = 0; kt < 4; ++kt) { f32x4 a = (f32x4){0.f, 0.f, 0.f, 0.f};
#pragma unroll
                for (int ks = 0; ks < 8; ++ks) { const bf16x8 kf = *(const LAS bf16x8*)(Ks + (kt * 16 + r) * KLD + ks * 32 + 8 * g);
                    a = __builtin_amdgcn_mfma_f32_16x16x32_bf16(kf, Qf[ks], a, 0, 0, 0); }
                s[ch * 4 + kt] = a; }
            __syncthreads();
        }
        float mx = -1e30f;
#pragma unroll
        for (int i = 0; i < 16; ++i) { s[i] = s[i] * 0.0625f; mx = fmaxf(mx, fmaxf(fmaxf(s[i][0], s[i][1]), fmaxf(s[i][2], s[i][3]))); }
        mx = fmaxf(mx, __shfl_xor(mx, 16)); mx = fmaxf(mx, __shfl_xor(mx, 32));
        float ps = 0.f;
#pragma unroll
        for (int i = 0; i < 16; ++i) {
#pragma unroll
            for (int j = 0; j < 4; ++j) { const float pv = __expf(s[i][j] - mx); s[i][j] = pv; ps += pv; } }
        ps += __shfl_xor(ps, 16); ps += __shfl_xor(ps, 32);
        const float inv = 1.f / ps;
#pragma unroll
        for (int k2 = 0; k2 < 8; ++k2) {
            u32x4 w; w.x = pack2(s[2 * k2][0] * inv, s[2 * k2][1] * inv); w.y = pack2(s[2 * k2][2] * inv, s[2 * k2][3] * inv);
            w.z = pack2(s[2 * k2 + 1][0] * inv, s[2 * k2 + 1][1] * inv); w.w = pack2(s[2 * k2 + 1][2] * inv, s[2 * k2 + 1][3] * inv);
            pf[k2] = __builtin_bit_cast(bf16x8, w); }
    }
    f32x4 Oacc[16];
#pragma unroll
    for (int dt = 0; dt < 16; ++dt) Oacc[dt] = (f32x4){0.f, 0.f, 0.f, 0.f};
#pragma unroll
    for (int ch = 0; ch < 4; ++ch) {
#pragma unroll
        for (int q = 0; q < 4; ++q) { const int pidx = tid + 512 * q; const int key = pidx >> 5, dc = pidx & 31; const u32x4 vv = stg[q];
            LAS bf16_t* vd = Vt + (dc * 8) * VLD + (key ^ ((dc & 15) << 2));
            vd[0 * VLD] = (bf16_t)(vv.x & 0xffff); vd[1 * VLD] = (bf16_t)(vv.x >> 16); vd[2 * VLD] = (bf16_t)(vv.y & 0xffff); vd[3 * VLD] = (bf16_t)(vv.y >> 16);
            vd[4 * VLD] = (bf16_t)(vv.z & 0xffff); vd[5 * VLD] = (bf16_t)(vv.z >> 16); vd[6 * VLD] = (bf16_t)(vv.w & 0xffff); vd[7 * VLD] = (bf16_t)(vv.w >> 16); }
        __syncthreads();
        if (ch < 3) XA_LOAD(Vp, ch + 1);
#pragma unroll
        for (int dt = 0; dt < 16; ++dt) { f32x4 o = Oacc[dt];
#pragma unroll
            for (int s2 = 0; s2 < 2; ++s2) { const int sw = ((dt * 2 + (r >> 3)) & 15) << 2; const LAS bf16_t* vrow = Vt + (dt * 16 + r) * VLD;
                const u32x2 lo = *(const LAS u32x2*)(vrow + ((s2 * 32 + 4 * g) ^ sw)), hi = *(const LAS u32x2*)(vrow + ((s2 * 32 + 16 + 4 * g) ^ sw));
                u32x4 w; w.x = lo.x; w.y = lo.y; w.z = hi.x; w.w = hi.y;
                o = __builtin_amdgcn_mfma_f32_16x16x32_bf16(__builtin_bit_cast(bf16x8, w), pf[ch * 2 + s2], o, 0, 0, 0); }
            Oacc[dt] = o; }
        __syncthreads();
    }
#undef XA_LOAD
#pragma unroll
    for (int dt = 0; dt < 16; ++dt) { u32x2 w; w.x = pack2(Oacc[dt][0], Oacc[dt][1]); w.y = pack2(Oacc[dt][2], Oacc[dt][3]);
        *(u32x2*)(O + (size_t)qrow * ldo + dt * 16 + 4 * g) = w; }
}

__device__ __forceinline__ void fox_kmax_tile(const Ctx& c, int l, int tile) {
    const int tid = otid();
    LAS unsigned* sm = (LAS unsigned*)c.lds;
    if (tid < 4) sm[tid] = 0u;
    __syncthreads();
    const size_t tok = (size_t)tile * 64 + (tid >> 3); const int part = tid & 7;
    const bf16_t* kp = c.P() + tok * PLD + C_FK + part * 32;
    float ss = 0.f;
#pragma unroll
    for (int q = 0; q < 4; ++q) { const u32x4 v = *(const u32x4*)(kp + q * 8);
        ss += bflo(v.x) * bflo(v.x) + bfhi(v.x) * bfhi(v.x) + bflo(v.y) * bflo(v.y) + bfhi(v.y) * bfhi(v.y) + bflo(v.z) * bflo(v.z) + bfhi(v.z) * bfhi(v.z) + bflo(v.w) * bflo(v.w) + bfhi(v.w) * bfhi(v.w); }
    ss += dpp_mov<0xB1>(ss);
    if ((part & 1) == 0) __hip_atomic_fetch_max((unsigned*)(sm + (part >> 1)), __float_as_uint(ss), __ATOMIC_RELAXED, __HIP_MEMORY_SCOPE_WORKGROUP);
    __syncthreads();
    if (tid < 4) atomicMax(c.KMAX() + l * 32 + (tile >> 5) * 4 + tid, sm[tid]);
    __syncthreads();
}

__device__ __forceinline__ void fox_block(LAS unsigned char* lds, const bf16_t* Q, const bf16_t* Kp, const bf16_t* Vp, bf16_t* O, int q0, const float* cvec, float kmax2) {
    constexpr int KLD = 72, VLD = 72, ldq = PLD, ldo = 256;
    constexpr int BUFB = (64 * KLD + 64 * VLD) * 2 + 256;
    const int tid = otid(), lane = tid & 63, wave = tid >> 6, r = lane & 15, g = lane >> 4;
    const int qrow = q0 + 16 * wave + r;
    bf16x8 Qf[2];
#pragma unroll
    for (int ks = 0; ks < 2; ++ks) Qf[ks] = *(const bf16x8*)(Q + (size_t)qrow * ldq + ks * 32 + 8 * g);
    float qn = 0.f;
#pragma unroll
    for (int ks = 0; ks < 2; ++ks)
#pragma unroll
        for (int j = 0; j < 8; ++j) { const float e = bf2f((bf16_t)Qf[ks][j]); qn += e * e; }
    qn += __shfl_xor(qn, 16); qn += __shfl_xor(qn, 32);
    constexpr float LOG2E = 1.4426950408889634f;
    const float mq = sqrtf(qn * kmax2) * 0.125f;
    const float cq = cvec[(size_t)qrow * 4];
    const float base2 = (cq - mq) * LOG2E;
    f32x4 Oacc[4];
#pragma unroll
    for (int dt = 0; dt < 4; ++dt) Oacc[dt] = (f32x4){0.f, 0.f, 0.f, 0.f};
    float lsum = 0.f;
    const int nch = (q0 + 128) / 64;
    const int key = tid >> 3, dc = tid & 7;
    u32x4 kreg, vreg; float ckr = 0.f;
#define FX_LOAD(chn) do { const int k0_ = (chn) * 64; kreg = *(const u32x4*)(Kp + (size_t)(k0_ + key) * PLD + dc * 8); vreg = *(const u32x4*)(Vp + (size_t)(k0_ + key) * PLD + dc * 8); \
        if (tid < 64) ckr = cvec[(size_t)(k0_ + tid) * 4]; } while (0)
#define FX_STAGE(chn) do { LAS bf16_t* Ks_ = (LAS bf16_t*)(lds + ((chn) & 1) * BUFB); LAS bf16_t* Vt_ = Ks_ + 64 * KLD; \
        *(LAS u32x4*)(Ks_ + key * KLD + dc * 8) = kreg; \
        LAS bf16_t* vd = Vt_ + (dc * 8) * VLD + (key ^ (dc << 2)); \
        vd[0 * VLD] = (bf16_t)(vreg.x & 0xffff); vd[1 * VLD] = (bf16_t)(vreg.x >> 16); vd[2 * VLD] = (bf16_t)(vreg.y & 0xffff); vd[3 * VLD] = (bf16_t)(vreg.y >> 16); \
        vd[4 * VLD] = (bf16_t)(vreg.z & 0xffff); vd[5 * VLD] = (bf16_t)(vreg.z >> 16); vd[6 * VLD] = (bf16_t)(vreg.w & 0xffff); vd[7 * VLD] = (bf16_t)(vreg.w >> 16); \
        if (tid < 64) ((LAS float*)(Vt_ + 64 * VLD))[tid] = ckr * LOG2E; } while (0)
    FX_LOAD(0); FX_STAGE(0);
    if (nch > 1) FX_LOAD(1);
    __syncthreads();
    for (int ch = 0; ch < nch; ++ch) {
        const int key0 = ch * 64;
        if (ch + 1 < nch) FX_STAGE(ch + 1);
        if (ch + 2 < nch) FX_LOAD(ch + 2);
        if (key0 <= q0 + 16 * wave + 15) {
            const LAS bf16_t* Ks = (const LAS bf16_t*)(lds + (ch & 1) * BUFB); const LAS bf16_t* Vt = Ks + 64 * KLD; const LAS float* ckb = (const LAS float*)(Vt + 64 * VLD);
            f32x4 s[4];
#pragma unroll
            for (int kt = 0; kt < 4; ++kt) { f32x4 a = (f32x4){0.f, 0.f, 0.f, 0.f};
#pragma unroll
                for (int ks = 0; ks < 2; ++ks) { const bf16x8 kf = *(const LAS bf16x8*)(Ks + (kt * 16 + r) * KLD + ks * 32 + 8 * g);
                    a = __builtin_amdgcn_mfma_f32_16x16x32_bf16(kf, Qf[ks], a, 0, 0, 0); }
                s[kt] = a; }
            const bool diag = key0 + 63 > q0 + 16 * wave;
            float ps = 0.f;
#pragma unroll
            for (int kt = 0; kt < 4; ++kt) { const f32x4 ck4 = *(const LAS f32x4*)(ckb + kt * 16 + 4 * g);
#pragma unroll
                for (int reg = 0; reg < 4; ++reg) { float pv = __builtin_amdgcn_exp2f(s[kt][reg] * (0.125f * LOG2E) + (base2 - ck4[reg]));
                    if (diag && key0 + kt * 16 + 4 * g + reg > qrow) pv = 0.f;
                    s[kt][reg] = pv; ps += pv; } }
            lsum += ps;
            bf16x8 pf[2];
#pragma unroll
            for (int s2 = 0; s2 < 2; ++s2) {
                u32x4 w; w.x = pack2(s[2 * s2][0], s[2 * s2][1]); w.y = pack2(s[2 * s2][2], s[2 * s2][3]); w.z = pack2(s[2 * s2 + 1][0], s[2 * s2 + 1][1]); w.w = pack2(s[2 * s2 + 1][2], s[2 * s2 + 1][3]);
                pf[s2] = __builtin_bit_cast(bf16x8, w); }
#pragma unroll
            for (int dt = 0; dt < 4; ++dt) { f32x4 o = Oacc[dt];
#pragma unroll
                for (int s2 = 0; s2 < 2; ++s2) { const int sw = ((dt * 2 + (r >> 3)) & 15) << 2; const LAS bf16_t* vrow = Vt + (dt * 16 + r) * VLD;
                    const u32x2 lo = *(const LAS u32x2*)(vrow + ((s2 * 32 + 4 * g) ^ sw)), hi = *(const LAS u32x2*)(vrow + ((s2 * 32 + 16 + 4 * g) ^ sw));
                    u32x4 w; w.x = lo.x; w.y = lo.y; w.z = hi.x; w.w = hi.y;
                    o = __builtin_amdgcn_mfma_f32_16x16x32_bf16(__builtin_bit_cast(bf16x8, w), pf[s2], o, 0, 0, 0); }
                Oacc[dt] = o; }
        }
        __syncthreads();
    }
#undef FX_LOAD
#undef FX_STAGE
    lsum += __shfl_xor(lsum, 16); lsum += __shfl_xor(lsum, 32);
    const float inv = 1.f / lsum;
#pragma unroll
    for (int dt = 0; dt < 4; ++dt) { u32x2 w; w.x = pack2(Oacc[dt][0] * inv, Oacc[dt][1] * inv); w.y = pack2(Oacc[dt][2] * inv, Oacc[dt][3] * inv);
        *(u32x2*)(O + (size_t)qrow * ldo + dt * 16 + 4 * g) = w; }
}

__device__ __forceinline__ void fox_item(const Ctx& c, int l, int s) {
    const int qt = 15 - (s >> 5), bh = s & 31, b = bh >> 2, h = bh & 3;
    const bf16_t* base = c.P() + (size_t)b * SEQ * PLD;
    const float kmax2 = __uint_as_float(c.KMAX()[l * 32 + bh]);
    fox_block(c.lds, base + C_FQ + h * 64, base + C_FK + h * 64, base + C_FV + h * 64,
              c.Y() + (size_t)3 * NTOK * 256 + (size_t)b * SEQ * 256 + h * 64, qt * 128, c.CF() + (size_t)b * SEQ * 4 + h, kmax2);
}

__device__ __forceinline__ void rw_post(const Ctx& c, int l) {
    const int tid = otid(), lane = tid & 63, wave = tid >> 6;
    const f32x4 lg = *(const f32x4*)(c.in(12) + l * 256 + 4 * lane), lb = *(const f32x4*)(c.in(13) + l * 256 + 4 * lane);
#pragma unroll 4
    for (int tok = c.bid * 8 + wave; tok < NTOK; tok += c.G * 8) {
        const f32x4 y = *(const f32x4*)(c.YRAW() + (size_t)tok * 256 + 4 * lane);
        const float mean = rsum16((y[0] + y[1]) + (y[2] + y[3])) * (1.f / 64.f);
        const f32x4 d = y - mean;
        const float var = rsum16((d[0] * d[0] + d[1] * d[1]) + (d[2] * d[2] + d[3] * d[3])) * (1.f / 64.f);
        const float rstd = rsqrtf(var + 64e-5f);
        f32x4 yn = d * rstd * lg + lb;
        const float bon = c.BON()[(size_t)tok * 4 + (lane >> 4)];
        const u32x2 vv = *(const u32x2*)(c.V() + (size_t)tok * 256 + 4 * lane), gg = *(const u32x2*)(c.Gg() + (size_t)tok * 256 + 4 * lane);
        yn[0] = (yn[0] + bon * bflo(vv.x)) * bflo(gg.x); yn[1] = (yn[1] + bon * bfhi(vv.x)) * bfhi(gg.x);
        yn[2] = (yn[2] + bon * bflo(vv.y)) * bflo(gg.y); yn[3] = (yn[3] + bon * bfhi(vv.y)) * bfhi(gg.y);
        u32x2 w; w.x = pack2(yn[0], yn[1]); w.y = pack2(yn[2], yn[3]);
        *(u32x2*)(c.Y() + (size_t)tok * 256 + 4 * lane) = w;
    }
}

__device__ __forceinline__ void ln_phase(const Ctx& c, int l, int which) {
    const int tid = otid(), lane = tid & 63, wave = tid >> 6;
    const float* gp = c.in(35) + (size_t)(l * 3 + which) * DM; const float* bp = c.in(36) + (size_t)(l * 3 + which) * DM;
    f32x4 gv[4], bv[4];
#pragma unroll
    for (int i = 0; i < 4; ++i) { gv[i] = *(const f32x4*)(gp + i * 256 + 4 * lane); bv[i] = *(const f32x4*)(bp + i * 256 + 4 * lane); }
#pragma unroll 2
    for (int row = c.bid * 8 + wave; row < NTOK; row += c.G * 8) {
        float* xr = c.X + (size_t)row * DM; f32x4 v[4]; float s = 0.f;
#pragma unroll
        for (int i = 0; i < 4; ++i) { v[i] = *(const f32x4*)(xr + i * 256 + 4 * lane); s += (v[i][0] + v[i][1]) + (v[i][2] + v[i][3]); }
        const float mean = wsum64(s) * (1.f / 1024.f); float q = 0.f;
#pragma unroll
        for (int i = 0; i < 4; ++i) { v[i] = v[i] - mean; q += (v[i][0] * v[i][0] + v[i][1] * v[i][1]) + (v[i][2] * v[i][2] + v[i][3] * v[i][3]); }
        const float rstd = rsqrtf(wsum64(q) * (1.f / 1024.f) + LN_EPS);
#pragma unroll
        for (int i = 0; i < 4; ++i) { const f32x4 y = v[i] * rstd * gv[i] + bv[i]; *(f32x4*)(xr + i * 256 + 4 * lane) = y;
            u32x2 w; w.x = pack2(y[0], y[1]); w.y = pack2(y[2], y[3]); *(u32x2*)(c.XB() + (size_t)row * DM + i * 256 + 4 * lane) = w; }
    }
}

#ifndef DUP_GEMM
#define DUP_GEMM 1
#endif
#ifndef DUP_MISC
#define DUP_MISC 1
#endif
__global__ void __launch_bounds__(512, 2) fwd_megakernel(Params p) {
    extern __shared__ __attribute__((aligned(16))) unsigned char lds_raw[];
    cg::grid_group grid = cg::this_grid();
    Ctx c; c.kin = (kin_t)__builtin_amdgcn_kernarg_segment_ptr(); c.ws = p.ws; c.X = p.out; c.lds = (LAS unsigned char*)lds_raw; c.G = gridDim.x; c.bid = blockIdx.x;
    const int G = c.G, bid = c.bid;

#ifndef PH
#define PH 0x3FFFF
#endif
    unsigned* barw = (unsigned*)(p.ws + WS_BAR);
    volatile LAS unsigned* stw = (volatile LAS unsigned*)(c.lds + 131072);
    if (threadIdx.x < 4) stw[threadIdx.x] = 0u;
    if (bid == 0) { for (int i = threadIdx.x; i < XCD_BAR_WORDS; i += 512) barw[i] = 0u; if (threadIdx.x < 128) c.KMAX()[threadIdx.x] = 0u; }
    prepass(c);
    grid.sync();
    const XcdBarrier xbar = xcd_barrier_post(barw, stw);
#define GSYNC() xcd_barrier(xbar)
    {
        pg8::Gemm g{c.Memb(), c.WkvT(), 1024, 1024, 1024}; pg8::StaticOrder S; S.init(2048, 8192, G, bid);
        pg8::EpiStoreBf16 E{c.KV(), 8192};
        if (PH & 0x10000) pg8::gemm_phase(c.lds, g, S, E);
    }
    for (int l = 0; l < DEPTH; ++l) {
        {
            pg8::Gemm g{c.XB(), c.WinT(), 1024, 1024, 1024}; pg8::StaticOrder S; S.init(NTOK, PLD, G, bid);
            pg8::EpiStoreBf16 E{c.P(), PLD};
            for (int d_ = 0; d_ < DUP_GEMM; ++d_) pg8::gemm_phase(c.lds, g, S, E);
        }
        GSYNC();
        for (int d_ = 0; d_ < DUP_MISC; ++d_) {
        if (PH & 4) for (int t = bid; t < 256; t += G) rw_prep_tile(c, l, t);
        if (PH & 8) for (int t = bid; t < 512; t += G) conv_tile(c, l, t);
        if (PH & 16) for (int t = bid; t < NB; t += G) fox_cumsum(c, l, t);
        for (int t = bid; t < 256; t += G) fox_kmax_tile(c, l, t);
        }
        GSYNC();
#ifndef DUP_P2B
#define DUP_P2B 1
#endif
        for (int rep = 0; rep < DUP_P2B; ++rep) {
#ifndef DUP_SCAN
#define DUP_SCAN 1
#endif
#ifndef DUP_GLA
#define DUP_GLA 1
#endif
#ifndef DUP_FOX
#define DUP_FOX 1
#endif
        if (bid < 128) { for (int d_ = 0; d_ < DUP_SCAN; ++d_) rw_scan_item(c, bid); }
        else if (bid < 160) { for (int d_ = 0; d_ < DUP_GLA; ++d_) gla_item(c, l, bid - 128); }
        else for (int d_ = 0; d_ < DUP_FOX; ++d_) { const int j = bid - 160, nbf = G - 160;
            for (int rnd = 0; rnd * nbf < 512; ++rnd) { const int pos = rnd * nbf + ((rnd & 1) ? (nbf - 1 - j) : j); if (pos < 512) fox_item(c, l, pos); } }
        GSYNC();
        }
        for (int d_ = 0; d_ < DUP_MISC; ++d_) rw_post(c, l);
        GSYNC();
        {
            pg8::Gemm g{c.Y(), c.UpT(), 256, 256, 256}; pg8::MergeOrder S; S.so.init(NTOK, 1024, G, bid);
            pg8::EpiMerge E{c.P(), c.in(26) + (size_t)l * 4 * 1024, c.XB()};
            for (int d_ = 0; d_ < DUP_MISC; ++d_) pg8::gemm_phase(c.lds, g, S, E);
        }
        GSYNC();
        {
            pg8::Gemm g{c.XB(), c.WoutT(), 1024, 1024, 1024}; pg8::StaticOrder S; S.init(NTOK, 1024, G, bid);
            pg8::EpiResid E{c.X};
            if (PH & 1024) pg8::gemm_phase(c.lds, g, S, E);
        }
        GSYNC();
        if (PH & 2048) ln_phase(c, l, 0);
        GSYNC();
        {
            pg8::Gemm g{c.XB(), c.WqT(), 1024, 1024, 1024}; pg8::StaticOrder S; S.init(NTOK, 1024, G, bid);
            pg8::EpiStoreBf16 E{c.Qb(), 1024};
            for (int d_ = 0; d_ < DUP_GEMM; ++d_) pg8::gemm_phase(c.lds, g, S, E);
        }
        GSYNC();
        for (int d_ = 0; d_ < DUP_MISC; ++d_) for (int it = bid; it < 512; it += G) { const int qt = it & 15, bh = it >> 4, b = bh >> 2, h = bh & 3;
            const bf16_t* kb = c.KV() + (size_t)b * 256 * 8192 + l * 2048 + h * 256;
            xattn_block(c.lds, c.Qb() + (size_t)b * SEQ * 1024 + h * 256, kb, kb + 1024, c.Ob() + (size_t)b * SEQ * 1024 + h * 256, qt * 128); }
        GSYNC();
        {
            pg8::Gemm g{c.Ob(), c.WoT(), 1024, 1024, 1024}; pg8::StaticOrder S; S.init(NTOK, 1024, G, bid);
            pg8::EpiResid E{c.X};
            if (PH & 1024) pg8::gemm_phase(c.lds, g, S, E);
        }
        GSYNC();
        if (PH & 2048) ln_phase(c, l, 1);
        GSYNC();
        {
            pg8::Gemm g{c.XB(), c.FfuT(), 1024, 1024, 1024}; pg8::StaticOrder S; S.init(NTOK, 2 * DFF, G, bid);
            pg8::EpiSwiglu E{c.Hb()};
            for (int d_ = 0; d_ < DUP_GEMM; ++d_) pg8::gemm_phase(c.lds, g, S, E);
        }
        GSYNC();
        {
            pg8::Gemm g{c.Hb(), c.FfdT(), DFF, DFF, DFF}; pg8::StaticOrder S; S.init(NTOK, 1024, G, bid);
            pg8::EpiResid E{c.X};
            if (PH & 1024) pg8::gemm_phase(c.lds, g, S, E);
        }
        GSYNC();
        if (PH & 2048) ln_phase(c, l, 2);
        if ((PH & 1) && l + 1 < DEPTH) { __syncthreads(); convert_layer(c, l + 1); }
        GSYNC();
    }
}

extern "C" void kernel_launch(void* const* d_in, const int* in_sizes, int n_in, void* d_out, int out_size, void* d_ws, size_t ws_size, hipStream_t stream) {
    static int grid_blocks = 0;
    if (grid_blocks == 0) {
        if (n_in != 37 || out_size != NTOK * DM || ws_size < WS_END) { fprintf(stderr, "kernel_launch: unexpected shapes (n_in %d out %d ws %zu need %zu)\n", n_in, out_size, ws_size, (size_t)WS_END); grid_blocks = -1; return; }
        if (hipFuncSetAttribute((const void*)fwd_megakernel, hipFuncAttributeMaxDynamicSharedMemorySize, LDS_BYTES) != hipSuccess) { fprintf(stderr, "kernel_launch: hipFuncSetAttribute failed\n"); grid_blocks = -1; return; }
        int dev = 0, cus = 0, per_cu = 0;
        (void)hipGetDevice(&dev); (void)hipDeviceGetAttribute(&cus, hipDeviceAttributeMultiprocessorCount, dev);
        (void)hipOccupancyMaxActiveBlocksPerMultiprocessor(&per_cu, (const void*)fwd_megakernel, 512, LDS_BYTES);
        if (per_cu < 1) { fprintf(stderr, "kernel_launch: occupancy query says %d blocks per CU\n", per_cu); per_cu = 1; }
        (void)hipGetLastError();
        grid_blocks = cus;
        if (grid_blocks < 192) { fprintf(stderr, "kernel_launch: too few CUs (%d)\n", cus); grid_blocks = -1; return; }
    }
    if (grid_blocks < 0) return;
    Params p{};
    for (int i = 0; i < 37; ++i) p.in[i] = (const float*)d_in[i];
    p.out = (float*)d_out; p.ws = (unsigned char*)d_ws;
    void* args[] = {&p};
    hipError_t e = hipLaunchCooperativeKernel((const void*)fwd_megakernel, dim3(grid_blocks), dim3(512), args, LDS_BYTES, stream);
    if (e != hipSuccess) fprintf(stderr, "cooperative launch failed: %s (grid %d)\n", hipGetErrorString(e), grid_blocks);
}
```
